# Optimizing an MI355X kernel written in HIP

```python
import math
import jax, jax.numpy as jnp
from jax import lax
import numpy as np

D_MODEL = 1024
BATCH = 2
SEQ = 8192
DEPTH = 2
DEC_BATCH = 32
DEC_SEQ = 1
PAST_LEN = 16384
PAGE_SIZE = 128

HEAD_DIM = 64
HEADS_PER_GROUP = 4
DIL_GROUPS = ((128, 1), (512, 4), (2048, 16))
N_ATTN_HEADS = HEADS_PER_GROUP * len(DIL_GROUPS)
QKV_W = N_ATTN_HEADS * HEAD_DIM
ATTN_OUT = HEADS_PER_GROUP * HEAD_DIM
Q_BLOCK = 128
NUM_BUCKETS = 32
MAX_DISTANCE = 2048
D_INNER = 2 * D_MODEL
SSD_HEAD_DIM = 64
SSD_HEADS = D_INNER // SSD_HEAD_DIM
SSD_GROUPS = 8
D_STATE = 128
D_CONV = 4
CONV_DIM = D_INNER + 2 * SSD_GROUPS * D_STATE
SSD_CHUNK = 128
D_FF = 4 * D_MODEL
EPS = 1e-6
N_IN = 3 * QKV_W + D_INNER + CONV_DIM + SSD_HEADS + 2 * D_MODEL

kernel_name = 'hybrid_dilated_attn_ssd_decoder_step'


def _rmsnorm(x, g):
    xf = x.astype(jnp.float32)
    y = xf * lax.rsqrt(jnp.mean(xf * xf, axis=-1, keepdims=True) + EPS)
    return (y * g.astype(jnp.float32)).astype(x.dtype)


def _gated_rmsnorm(y, z, g):
    b, L = y.shape[:2]
    h = (y * jax.nn.silu(z)).astype(jnp.float32).reshape(b, L, SSD_GROUPS, D_INNER // SSD_GROUPS)
    h = h * lax.rsqrt(jnp.mean(h * h, axis=-1, keepdims=True) + EPS)
    return (h.reshape(b, L, D_INNER) * g.astype(jnp.float32)).astype(y.dtype)


def _split_cols(t):
    sizes = (QKV_W, QKV_W, QKV_W, D_INNER, CONV_DIM, SSD_HEADS, 2 * D_MODEL)
    outs, start = [], 0
    for n in sizes:
        outs.append(t[..., start:start + n])
        start += n
    return outs


def _t5_bucket(dist):
    max_exact = NUM_BUCKETS // 2
    df = jnp.maximum(dist, 1).astype(jnp.float32)
    large = max_exact + (jnp.log(df / max_exact) / math.log(MAX_DISTANCE / max_exact)
                         * (NUM_BUCKETS - max_exact)).astype(jnp.int32)
    large = jnp.minimum(large, NUM_BUCKETS - 1)
    return jnp.where(dist < max_exact, dist, large)


def _dilated_group(q, k, v, bias, dil, q_off):
    b, Lq, H, hd = q.shape
    Lk = k.shape[1]
    nk = bias.shape[0]
    qb = min(Q_BLOCK, Lq)
    nb = -(-Lq // qb)
    pad = nb * qb - Lq
    qp = jnp.pad(q, ((0, 0), (0, pad), (0, 0), (0, 0)))
    qp = qp.reshape(b, nb, qb, H, hd).transpose(1, 0, 2, 3, 4)
    steps = jnp.arange(nk, dtype=jnp.int32) * dil
    scale = hd ** -0.5
    bias_t = bias.astype(jnp.float32).T

    def block(args):
        bi, qblk = args
        pos = q_off + bi * qb + jnp.arange(qb, dtype=jnp.int32)[:, None] - steps[None, :]
        valid = pos >= 0
        idx = jnp.clip(pos, 0, Lk - 1)
        kg = k[:, idx]
        vg = v[:, idx]
        s = jnp.einsum('bqhd,bqjhd->bqhj', qblk, kg).astype(jnp.float32) * scale + bias_t
        s = jnp.where(valid[None, :, None, :], s, -jnp.inf)
        lse = jax.nn.logsumexp(s, axis=-1)
        p = jnp.exp(s - lse[..., None]).astype(v.dtype)
        o = jnp.einsum('bqhj,bqjhd->bqhd', p, vg)
        return o, lse

    o, lse = lax.map(block, (jnp.arange(nb, dtype=jnp.int32), qp))
    o = o.transpose(1, 0, 2, 3, 4).reshape(b, nb * qb, H, hd)[:, :Lq]
    lse = lse.transpose(1, 0, 2, 3).reshape(b, nb * qb, H)[:, :Lq]
    return o, lse


def _dilated_mixer(q, k, v, rel_bias, kv_bufs):
    b, L = q.shape[:2]
    outs, lses, new_bufs = [], [], []
    for g, (win, dil) in enumerate(DIL_GROUPS):
        hs = slice(g * HEADS_PER_GROUP, (g + 1) * HEADS_PER_GROUP)
        qg, kg, vg = q[:, :, hs], k[:, :, hs], v[:, :, hs]
        nk = win // dil + 1
        bias = rel_bias[_t5_bucket(jnp.arange(nk, dtype=jnp.int32) * dil)][:, hs]
        rows = jnp.stack([kg, vg], axis=2)
        if kv_bufs is None:
            kk, vv, off = kg, vg, 0
            keep = min(win, L)
            new_bufs.append(rows[:, L - keep:])
        else:
            buf = kv_bufs[g].astype(q.dtype)
            off = buf.shape[1]
            kk = jnp.concatenate([buf[:, :, 0], kg], axis=1)
            vv = jnp.concatenate([buf[:, :, 1], vg], axis=1)
            new_bufs.append(jnp.concatenate([buf, rows], axis=1)[:, -off:])
        o, lse = _dilated_group(qg, kk, vv, bias, dil, off)
        outs.append(o)
        lses.append(lse)
    w = jax.nn.softmax(jnp.stack(lses, axis=0), axis=0)
    o = jnp.einsum('gblh,gblhd->blhd', w.astype(q.dtype), jnp.stack(outs, axis=0))
    return o.reshape(b, L, ATTN_OUT), new_bufs


def _segsum(a):
    T = a.shape[-1]
    x = jnp.broadcast_to(a[..., None], a.shape + (T,))
    x = jnp.where(jnp.tril(jnp.ones((T, T), bool), -1), x, 0.0)
    s = jnp.cumsum(x, axis=-2)
    return jnp.where(jnp.tril(jnp.ones((T, T), bool)), s, -jnp.inf)


def _ssd(x, dt, A, Bm, Cm, h0):
    b, L, H, P = x.shape
    G, N = Bm.shape[2], Bm.shape[3]
    E = H // G
    Q = min(SSD_CHUNK, L)
    nc = -(-L // Q)
    pad = nc * Q - L

    def padf(t):
        return jnp.pad(t, [(0, 0), (0, pad)] + [(0, 0)] * (t.ndim - 2))

    xf = padf(x.astype(jnp.float32) * dt[..., None]).reshape(b, nc, Q, G, E, P)
    a = padf(dt * A).reshape(b, nc, Q, G, E).transpose(0, 1, 3, 4, 2)
    Bc = padf(Bm.astype(jnp.float32)).reshape(b, nc, Q, G, N)
    Cc = padf(Cm.astype(jnp.float32)).reshape(b, nc, Q, G, N)
    a_cs = jnp.cumsum(a, axis=-1)
    lmat = jnp.exp(_segsum(a))
    cb = jnp.einsum('bclgn,bcsgn->bcgls', Cc, Bc)
    y_diag = jnp.einsum('bcgels,bcsgep->bclgep', cb[:, :, :, None] * lmat, xf)
    decay_states = jnp.exp(a_cs[..., -1:] - a_cs).transpose(0, 1, 4, 2, 3)
    states = jnp.einsum('bclgn,bclgep->bcgepn', Bc, xf * decay_states[..., None])
    states = jnp.concatenate([h0.reshape(b, 1, G, E, P, N), states], axis=1)
    chunk_decay = jnp.pad(a_cs[..., -1].transpose(0, 2, 3, 1), ((0, 0), (0, 0), (0, 0), (1, 0)))
    dc = jnp.exp(_segsum(chunk_decay))
    new_states = jnp.einsum('bgezc,bcgepn->bzgepn', dc, states)
    y_off = jnp.einsum('bclgn,bcgepn->bclgep', Cc, new_states[:, :-1]) \
        * jnp.exp(a_cs).transpose(0, 1, 4, 2, 3)[..., None]
    y = (y_diag + y_off).reshape(b, nc * Q, H, P)[:, :L]
    return y, new_states[:, -1].reshape(b, H, P, N)


def _causal_conv(xbc, buf, w, bias):
    L = xbc.shape[1]
    xp = jnp.concatenate([buf, xbc], axis=1)
    y = bias + xp[:, 0:L] * w[0]
    for t in range(1, D_CONV):
        y = y + xp[:, t:t + L] * w[t]
    return jax.nn.silu(y), xp[:, L:]


def _ssd_mixer(z, xbc, dt_raw, conv_buf, h0, conv_w, conv_b, dt_bias, a_log, d_skip, norm_g):
    b, L = z.shape[:2]
    xbc, new_buf = _causal_conv(xbc, conv_buf, conv_w, conv_b)
    xs = xbc[..., :D_INNER].reshape(b, L, SSD_HEADS, SSD_HEAD_DIM)
    Bm = xbc[..., D_INNER:D_INNER + SSD_GROUPS * D_STATE].reshape(b, L, SSD_GROUPS, D_STATE)
    Cm = xbc[..., D_INNER + SSD_GROUPS * D_STATE:].reshape(b, L, SSD_GROUPS, D_STATE)
    dt = jax.nn.softplus(dt_raw.astype(jnp.float32) + dt_bias.astype(jnp.float32))
    A = -jnp.exp(a_log.astype(jnp.float32))
    y, h = _ssd(xs, dt, A, Bm, Cm, h0)
    y = y + d_skip.astype(jnp.float32)[:, None] * xs.astype(jnp.float32)
    y = _gated_rmsnorm(y.reshape(b, L, D_INNER).astype(z.dtype), z, norm_g)
    return y, new_buf, h


def _trunk(x, c, kv_caches, ssm_state, conv_state, rel_bias, w_ada, b_ada, norm1_g, norm2_g,
           w_in, conv_w, conv_b, dt_bias, a_log, d_skip, ssd_norm_g, w_o_attn, w_o_ssd,
           w_out, w_up, w_down, final_g):
    b, L, _ = x.shape
    new_kv = [[] for _ in DIL_GROUPS]
    new_ssm, new_conv = [], []
    for l in range(DEPTH):
        if kv_caches is None:
            bufs = None
            conv_buf = jnp.zeros((b, D_CONV - 1, CONV_DIM), x.dtype)
            h0 = jnp.zeros((b, SSD_HEADS, SSD_HEAD_DIM, D_STATE), jnp.float32)
        else:
            bufs = [cache[l] for cache in kv_caches]
            conv_buf = conv_state[l].astype(x.dtype)
            h0 = ssm_state[l].astype(jnp.float32)
        mod = jax.nn.silu(c) @ w_ada[l] + b_ada[l]
        sh1, sc1, g1, sh2, sc2, g2 = jnp.split(mod[:, None, :], 6, axis=-1)
        h = _rmsnorm(x, norm1_g[l]) * (1 + sc1) + sh1
        q, k, v, z, xbc, dt_raw, gates = _split_cols(h @ w_in[l])
        q = q.reshape(b, L, N_ATTN_HEADS, HEAD_DIM)
        k = k.reshape(b, L, N_ATTN_HEADS, HEAD_DIM)
        v = v.reshape(b, L, N_ATTN_HEADS, HEAD_DIM)
        attn, bufs_new = _dilated_mixer(q, k, v, rel_bias, bufs)
        ssd, conv_new, h_new = _ssd_mixer(z, xbc, dt_raw, conv_buf, h0, conv_w[l], conv_b[l],
                                          dt_bias[l], a_log[l], d_skip[l], ssd_norm_g[l])
        g_attn, g_ssd = jnp.split(jax.nn.sigmoid(gates), 2, axis=-1)
        merged = g_attn * (attn @ w_o_attn[l]) + g_ssd * (ssd @ w_o_ssd[l])
        x = x + g1 * (merged @ w_out[l])
        h = _rmsnorm(x, norm2_g[l]) * (1 + sc2) + sh2
        x = x + g2 * (jnp.square(jax.nn.relu(h @ w_up[l])) @ w_down[l])
        for g in range(len(DIL_GROUPS)):
            new_kv[g].append(bufs_new[g])
        new_ssm.append(h_new.astype(x.dtype))
        new_conv.append(conv_new)
    y = _rmsnorm(x, final_g)
    return y, [jnp.stack(n, axis=0) for n in new_kv], jnp.stack(new_ssm, axis=0), jnp.stack(new_conv, axis=0)


def setup_inputs(seed: int = 0) -> dict:
    key = jax.random.key(seed)
    ks = jax.random.split(key, 32)
    f32 = jnp.float32

    def nrm(k, shape, s):
        return jax.random.normal(k, shape, f32) * s

    lb = [min(w, PAST_LEN) for (w, _) in DIL_GROUPS]
    dt0 = jnp.exp(jax.random.uniform(ks[17], (DEPTH, SSD_HEADS), f32, math.log(1e-3), math.log(1e-1)))
    return {
        'x_prompt': nrm(ks[0], (BATCH, SEQ, D_MODEL), 1.0),
        'x_sample': nrm(ks[1], (DEC_BATCH, DEC_SEQ, D_MODEL), 1.0),
        'cache_kv_g0': nrm(ks[2], (DEPTH, DEC_BATCH, lb[0], 2, HEADS_PER_GROUP, HEAD_DIM), 1.0),
        'cache_kv_g1': nrm(ks[3], (DEPTH, DEC_BATCH, lb[1], 2, HEADS_PER_GROUP, HEAD_DIM), 1.0),
        'cache_kv_g2': nrm(ks[4], (DEPTH, DEC_BATCH, lb[2], 2, HEADS_PER_GROUP, HEAD_DIM), 1.0),
        'state_ssm': nrm(ks[5], (DEPTH, DEC_BATCH, SSD_HEADS, SSD_HEAD_DIM, D_STATE), 0.1),
        'state_conv': nrm(ks[6], (DEPTH, DEC_BATCH, D_CONV - 1, CONV_DIM), 1.0),
        'c_prompt': nrm(ks[7], (BATCH, D_MODEL), 1.0),
        'c_sample': nrm(ks[8], (DEC_BATCH, D_MODEL), 1.0),
        'rel_bias': nrm(ks[9], (NUM_BUCKETS, N_ATTN_HEADS), 0.5),
        'w_ada': nrm(ks[10], (DEPTH, D_MODEL, 6 * D_MODEL), 0.5 * D_MODEL ** -0.5),
        'b_ada': nrm(ks[11], (DEPTH, 6 * D_MODEL), 0.02),
        'norm1_g': 1.0 + nrm(ks[12], (DEPTH, D_MODEL), 0.02),
        'norm2_g': 1.0 + nrm(ks[13], (DEPTH, D_MODEL), 0.02),
        'w_in': nrm(ks[14], (DEPTH, D_MODEL, N_IN), D_MODEL ** -0.5),
        'conv_w': nrm(ks[15], (DEPTH, D_CONV, CONV_DIM), D_CONV ** -0.5),
        'conv_b': nrm(ks[16], (DEPTH, CONV_DIM), 0.02),
        'dt_bias': dt0 + jnp.log(-jnp.expm1(-dt0)),
        'a_log': jnp.log(jax.random.uniform(ks[18], (DEPTH, SSD_HEADS), f32, 1.0, 16.0)),
        'd_skip': 1.0 + nrm(ks[19], (DEPTH, SSD_HEADS), 0.02),
        'ssd_norm_g': 1.0 + nrm(ks[20], (DEPTH, D_INNER), 0.02),
        'w_o_attn': nrm(ks[21], (DEPTH, ATTN_OUT, D_MODEL), ATTN_OUT ** -0.5),
        'w_o_ssd': nrm(ks[22], (DEPTH, D_INNER, D_MODEL), D_INNER ** -0.5),
        'w_out': nrm(ks[23], (DEPTH, D_MODEL, D_MODEL), D_MODEL ** -0.5),
        'w_up': nrm(ks[24], (DEPTH, D_MODEL, D_FF), D_MODEL ** -0.5),
        'w_down': nrm(ks[25], (DEPTH, D_FF, D_MODEL), D_FF ** -0.5),
        'final_g': 1.0 + nrm(ks[26], (D_MODEL,), 0.02),
    }


def reference(x_prompt, x_sample, cache_kv_g0, cache_kv_g1, cache_kv_g2, state_ssm, state_conv,
              c_prompt, c_sample, rel_bias, w_ada, b_ada, norm1_g, norm2_g, w_in, conv_w, conv_b,
              dt_bias, a_log, d_skip, ssd_norm_g, w_o_attn, w_o_ssd, w_out, w_up, w_down, final_g):
    weights = (rel_bias, w_ada, b_ada, norm1_g, norm2_g, w_in, conv_w, conv_b, dt_bias, a_log,
               d_skip, ssd_norm_g, w_o_attn, w_o_ssd, w_out, w_up, w_down, final_g)
    y_prompt, kv_p, ssm_prompt, conv_prompt = _trunk(x_prompt, c_prompt, None, None, None, *weights)
    y_sample, kv_s, ssm_sample, conv_sample = _trunk(
        x_sample, c_sample, (cache_kv_g0, cache_kv_g1, cache_kv_g2), state_ssm, state_conv, *weights)
    return (y_prompt, y_sample, kv_p[0], kv_p[1], kv_p[2], ssm_prompt, conv_prompt,
            kv_s[0], kv_s[1], kv_s[2], ssm_sample, conv_sample)
```

```cpp
#include <hip/hip_runtime.h>
#include <hip/hip_cooperative_groups.h>
#include <cstdio>
#include <cstdint>
namespace cg = cooperative_groups;

#ifndef MK_ONE_LAUNCH
#define MK_ONE_LAUNCH 1
#endif

#define LAS __attribute__((address_space(3)))
typedef unsigned short bf16_t;
typedef short bf16x8 __attribute__((ext_vector_type(8)));
typedef short s16x4 __attribute__((ext_vector_type(4)));
typedef float f32x4 __attribute__((ext_vector_type(4)));
typedef float f32x2 __attribute__((ext_vector_type(2)));
typedef unsigned u32x4 __attribute__((ext_vector_type(4)));
typedef unsigned u32x2 __attribute__((ext_vector_type(2)));

constexpr int D = 1024, SEQ = 8192, NBP = 2, NBS = 32, MP = NBP * SEQ, MV = MP + NBS, M = MP + 256, NMB = NBP + NBS;
constexpr int NIN = 10528, NINP = 10752, DFF = 4096, DIN = 2048, NH = 32, NLAYER = 2;
constexpr int CQ = 0, CK = 768, CV = 1536, CZ = 2304, CX = 4352, CG = 8448, CDT = 10496;
constexpr float EPS = 1e-6f;
constexpr int NSC = 8;

constexpr size_t AL(size_t x) { return (x + 255) & ~(size_t)255; }
constexpr size_t WS_CTL = 0;
constexpr size_t WS_MOD = (size_t)1 << 20;
constexpr size_t WS_BIAS1 = WS_MOD + AL((size_t)NLAYER * NMB * 6144 * 4);
constexpr size_t WS_BIAS2 = WS_BIAS1 + AL((size_t)NLAYER * NMB * NINP * 4);
constexpr size_t WS_BTAB = WS_BIAS2 + AL((size_t)NLAYER * NMB * DFF * 4);
constexpr size_t WS_SSA = WS_BTAB + AL(12 * 132 * 4);
constexpr size_t WS_SSB = WS_SSA + AL((size_t)M * 16 * 4);
constexpr size_t WS_DT = WS_SSB + AL((size_t)M * 16 * 4);
constexpr size_t WS_ACUM = WS_DT + AL((size_t)M * 32 * 4);
constexpr size_t WS_ATOT = WS_ACUM + AL((size_t)M * 32 * 4);
constexpr size_t WS_LSE = WS_ATOT + AL(NBP * NH * NSC * 4);
constexpr size_t WS_HLOC = WS_LSE + AL((size_t)3 * M * 4 * 4);
constexpr size_t WS_W = WS_HLOC + AL((size_t)NBP * NH * NSC * 8192 * 4);
constexpr size_t WL_IN = 0, WL_OA = WL_IN + (size_t)NINP * D * 2, WL_OS = WL_OA + (size_t)D * 256 * 2, WL_OUT = WL_OS + (size_t)D * DIN * 2,
                 WL_UP = WL_OUT + (size_t)D * D * 2, WL_DN = WL_UP + (size_t)DFF * D * 2, WL_SIZE = WL_DN + (size_t)D * DFF * 2;
constexpr size_t WS_XG1 = WS_W + NLAYER * WL_SIZE;
constexpr size_t WS_XG2 = WS_XG1 + (size_t)M * D * 2;
constexpr size_t WS_X1 = WS_XG2 + (size_t)M * D * 2;
constexpr size_t WS_XA = WS_X1 + (size_t)M * D * 4;
constexpr size_t WS_ATTN = WS_XA + (size_t)M * D * 4;
constexpr size_t WS_SSDN = WS_ATTN + (size_t)M * 256 * 2;
constexpr size_t WS_VT = WS_SSDN + (size_t)M * DIN * 2;
constexpr size_t WS_CB = WS_VT + (size_t)NBP * 12 * 64 * SEQ * 2;
constexpr size_t WS_OG = WS_CB + (size_t)MP * 1024 * 2;
constexpr size_t WS_YL = WS_OG + (size_t)3 * M * 256 * 4;
constexpr size_t WS_T1 = WS_YL, WS_MERGED = WS_YL + (size_t)M * D * 4;
constexpr size_t WS_ACT = WS_YL + (size_t)M * DIN * 4;
constexpr size_t WS_U = WS_ACT;
constexpr size_t WS_END = WS_ACT + (size_t)M * NINP * 2;
static_assert(WS_MERGED + (size_t)M * D * 2 <= WS_ACT, "overlay");
static_assert(WS_END <= ((size_t)1 << 30), "workspace map must fit 1 GiB");

constexpr size_t O_YP = 0;
constexpr size_t O_YS = O_YP + (size_t)MP * D;
constexpr size_t O_KVP0 = O_YS + (size_t)NBS * D;
constexpr size_t O_KVP1 = O_KVP0 + (size_t)2 * 2 * 128 * 512;
constexpr size_t O_KVP2 = O_KVP1 + (size_t)2 * 2 * 512 * 512;
constexpr size_t O_SSMP = O_KVP2 + (size_t)2 * 2 * 2048 * 512;
constexpr size_t O_CONVP = O_SSMP + (size_t)2 * 2 * 32 * 8192;
constexpr size_t O_KVS0 = O_CONVP + (size_t)2 * 2 * 3 * 4096;
constexpr size_t O_KVS1 = O_KVS0 + (size_t)2 * 32 * 128 * 512;
constexpr size_t O_KVS2 = O_KVS1 + (size_t)2 * 32 * 512 * 512;
constexpr size_t O_SSMS = O_KVS2 + (size_t)2 * 32 * 2048 * 512;
constexpr size_t O_CONVS = O_SSMS + (size_t)2 * 32 * 32 * 8192;
constexpr size_t O_END = O_CONVS + (size_t)2 * 32 * 3 * 4096;

__device__ __forceinline__ float bf2f(unsigned h) { return __uint_as_float(h << 16); }
__device__ __forceinline__ unsigned f2bf(float f) { unsigned u = __float_as_uint(f); return (u + 0x7fffu + ((u >> 16) & 1u)) >> 16; }
__device__ __forceinline__ unsigned cvt_pk_bf16(float lo, float hi) { unsigned r; asm volatile("v_cvt_pk_bf16_f32 %0, %1, %2" : "=v"(r) : "v"(lo), "v"(hi)); return r; }
__device__ __forceinline__ float blo(unsigned w) { return __uint_as_float(w << 16); }
__device__ __forceinline__ float bhi(unsigned w) { return __uint_as_float(w & 0xffff0000u); }
__device__ __forceinline__ float sigmoidf_(float x) { return 1.0f / (1.0f + __expf(-x)); }
__device__ __forceinline__ float siluf_(float x) { return x / (1.0f + __expf(-x)); }
__device__ __forceinline__ float softplusf_(float x) { return fmaxf(x, 0.f) + log1pf(__expf(-fabsf(x))); }
__device__ __forceinline__ int mbof(int r) { return r < MP ? (r >> 13) : (r - MP + NBP < NMB ? r - MP + NBP : NMB - 1); }
__device__ __forceinline__ float wave_sum(float v) {
#pragma unroll
    for (int o = 1; o < 64; o <<= 1) v += __shfl_xor(v, o);
    return v;
}
__device__ __forceinline__ float wave_max(float v) {
#pragma unroll
    for (int o = 1; o < 64; o <<= 1) v = fmaxf(v, __shfl_xor(v, o));
    return v;
}
typedef short v4i16_t __attribute__((ext_vector_type(4)));
__device__ __forceinline__ s16x4 tr16(const LAS unsigned char* p) { return __builtin_bit_cast(s16x4, __builtin_amdgcn_ds_read_tr16_b64_v4i16((LAS v4i16_t*)p)); }
#define MFMA16(a, b, c) __builtin_amdgcn_mfma_f32_16x16x32_bf16((a), (b), (c), 0, 0, 0)

namespace pg8 {
constexpr int BM = 256, BK = 64, HALF = 128, HTB = HALF * BK * 2, STAGE_BYTES = 8 * HTB, NXCD = 8, WGM = 8;
__host__ __device__ __forceinline__ int lds_byte(int r, int c) { const int st = (r >> 4) * 2 + (c >> 5), rr = r & 15, cc = c & 31, ob = rr * 64 + cc * 2; return st * 1024 + (ob ^ (((ob >> 9) & 1) << 5)); }
__host__ __device__ __forceinline__ void stage_rc(int b, int& R, int& C) { const int st = b / 1024, sb = b % 1024, swz = sb ^ (((sb >> 9) & 1) << 5); R = (st >> 1) * 16 + swz / 64; C = (st & 1) * 32 + (swz % 64) / 2; }
__host__ __device__ __forceinline__ int perm32(int rho) { const int n = rho >> 4, i = rho & 15; return 8 * (i >> 2) + 4 * n + (i & 3); }
struct Unit { int pm, pn; };
struct Gemm { const bf16_t* A; const bf16_t* Bt; int M, N, K; };
struct StaticOrder {
    int nM, nN, nwg, G, c;
    __host__ __device__ void init(int M_, int N_, int G_, int c_) { nM = M_ / BM; nN = N_ / BM; nwg = nM * nN; G = G_; c = c_; }
    __host__ __device__ bool next(int i, Unit& u) const {
        const long L = (long)i * G + c; if (L >= nwg) return false;
        int wgid = (int)L; { const int q = nwg / NXCD, r = nwg % NXCD, xcd = wgid % NXCD, off = wgid / NXCD; wgid = (xcd < r ? xcd * (q + 1) : r * (q + 1) + (xcd - r) * q) + off; }
        const int nig = WGM * nN, gid = wgid / nig, fm = gid * WGM, gsz = (nM - fm) < WGM ? (nM - fm) : WGM;
        u.pm = fm + ((wgid % nig) % gsz); u.pn = (wgid % nig) / gsz; return true;
    }
    __device__ __forceinline__ void a_ready(const Unit&) const {}
    __device__ __forceinline__ void done(const Unit&) const {}
};

template <class Epi, class Sched, bool ALIGN_EPI = false, bool SP2 = false>
__device__ __forceinline__ void gemm_phase(LAS unsigned char* lds, const Gemm g, const Sched& S, const Epi& E, int wid_in) {
    int wid = wid_in; asm volatile("" : "+s"(wid));
    int lane; asm volatile("v_mbcnt_lo_u32_b32 %0, -1, 0\n\tv_mbcnt_hi_u32_b32 %0, -1, %0" : "=v"(lane));
    const int tid = wid * 64 + lane, wr = wid >> 2, wc = wid & 3, fr = lane & 15, fq = lane >> 4;
    const int K = g.K, nt = K / BK;
    unsigned voffA[2], voffB[2];
#pragma unroll
    for (int i = 0; i < 2; ++i) { int R, C; stage_rc(tid * 16 + i * 8192, R, C); const int Rb = Epi::PERM ? ((R & ~31) + perm32(R & 31)) : R;
        voffA[i] = (unsigned)(R * K + C) * 2u; voffB[i] = (unsigned)(Rb * K + C) * 2u; }
    const size_t kstep = (size_t)(BK * 2);
    const size_t hstep = (size_t)HALF * K * 2;
    const size_t tstep = 2 * hstep;
    const unsigned ldsw = (unsigned)wid * 1024u;
    const int aoff = lds_byte(wr * 64 + fr, fq * 8), boff = lds_byte(wc * 32 + fr, fq * 8);
#define PG8_SA(b, h) (((b) * 2 + (h)) * HTB)
#define PG8_SB(b, h) ((4 + (b) * 2 + (h)) * HTB)
#define PG8_STAGE(bufoff, gbase, voff) do { _Pragma("unroll") for (int _i = 0; _i < 2; ++_i) \
        __builtin_amdgcn_global_load_lds((const unsigned*)((const char*)(gbase) + (voff)[_i]), (LAS unsigned*)(lds + (bufoff) + ldsw + _i * 8192), 16, 0, 0); } while (0)
#define PG8_LDA(dst, b, h) do { _Pragma("unroll") for (int m = 0; m < 4; ++m) _Pragma("unroll") for (int k = 0; k < 2; ++k) dst[m][k] = *(const LAS bf16x8*)(lds + PG8_SA(b, h) + aoff + m * 2048 + k * 1024); } while (0)
#define PG8_LDB(dst, b, h) do { _Pragma("unroll") for (int n = 0; n < 2; ++n) _Pragma("unroll") for (int k = 0; k < 2; ++k) dst[n][k] = *(const LAS bf16x8*)(lds + PG8_SB(b, h) + boff + n * 2048 + k * 1024); } while (0)
#define PG8_MMA(ai, bj, At, Bt) do { __builtin_amdgcn_s_setprio(1); _Pragma("unroll") for (int m = 0; m < 4; ++m) _Pragma("unroll") for (int n = 0; n < 2; ++n) _Pragma("unroll") for (int k = 0; k < 2; ++k) \
        acc[ai][bj][m][n] = __builtin_amdgcn_mfma_f32_16x16x32_bf16(Bt[n][k], At[m][k], acc[ai][bj][m][n], 0, 0, 0); __builtin_amdgcn_s_setprio(0); } while (0)
#define PG8_WAIT_V(n) asm volatile("s_waitcnt vmcnt(" #n ")" ::: "memory")
#define PG8_WAIT_L(n) asm volatile("s_waitcnt lgkmcnt(" #n ")" ::: "memory")
#define PG8_BAR __builtin_amdgcn_s_barrier()
#define PG8_SCHED __builtin_amdgcn_sched_barrier(0)
    Unit cur, nxt; int ui = 0;
    if (!S.next(0, cur)) return;
    f32x4 acc[2][2][4][2];
#pragma unroll
    for (int a = 0; a < 2; ++a)
#pragma unroll
        for (int b = 0; b < 2; ++b)
#pragma unroll
            for (int m = 0; m < 4; ++m)
#pragma unroll
                for (int n = 0; n < 2; ++n) acc[a][b][m][n] = (f32x4){0.f, 0.f, 0.f, 0.f};
    bf16x8 At[4][2], B0[2][2], B1[2][2];
    const char* cA = (const char*)g.A + (size_t)cur.pm * tstep; const char* cB = (const char*)g.Bt + (size_t)cur.pn * tstep;
    S.a_ready(cur);
    if constexpr (SP2) {
        PG8_STAGE(PG8_SB(0, 0), cB, voffB); PG8_STAGE(PG8_SB(0, 1), cB + hstep, voffB); PG8_STAGE(PG8_SA(0, 0), cA, voffA); PG8_STAGE(PG8_SA(0, 1), cA + hstep, voffA);
        if (wr == 1) PG8_BAR;
        PG8_WAIT_V(2); PG8_BAR;
        PG8_STAGE(PG8_SB(1, 0), cB + kstep, voffB); PG8_STAGE(PG8_SA(1, 0), cA + kstep, voffA); PG8_STAGE(PG8_SB(1, 1), cB + hstep + kstep, voffB);
        PG8_WAIT_V(6); PG8_BAR;
    } else {
        PG8_STAGE(PG8_SB(0, 0), cB, voffB); PG8_STAGE(PG8_SA(0, 0), cA, voffA); PG8_STAGE(PG8_SB(0, 1), cB + hstep, voffB); PG8_STAGE(PG8_SA(0, 1), cA + hstep, voffA);
        if (wr == 1) PG8_BAR;
        PG8_WAIT_V(4); PG8_BAR;
        PG8_STAGE(PG8_SB(1, 0), cB + kstep, voffB); PG8_STAGE(PG8_SA(1, 0), cA + kstep, voffA); PG8_STAGE(PG8_SB(1, 1), cB + hstep + kstep, voffB);
        PG8_WAIT_V(6); PG8_BAR;
    }
    for (;;) {
        const bool has_next = S.next(ui + 1, nxt);
        const char* nA = has_next ? (const char*)g.A + (size_t)nxt.pm * tstep : cA; const char* nB = has_next ? (const char*)g.Bt + (size_t)nxt.pn * tstep : cB;
#pragma unroll 1
        for (int t = 0; t < nt; t += 2) {
            const bool last = (t == nt - 2);
            const char* a1 = cA + (size_t)(t + 1) * kstep;
            const char* a2 = last ? nA : cA + (size_t)(t + 2) * kstep; const char* b2 = last ? nB : cB + (size_t)(t + 2) * kstep;
            const char* a3 = a2 + kstep; const char* b3 = b2 + kstep;
            if (last && has_next) S.a_ready(nxt);
            if constexpr (SP2) {
            PG8_LDB(B0, 0, 0); PG8_LDB(B1, 0, 1); PG8_SCHED; PG8_LDA(At, 0, 0); PG8_STAGE(PG8_SA(1, 1), a1 + hstep, voffA);
            PG8_WAIT_V(8); PG8_WAIT_L(0); PG8_BAR; PG8_MMA(0, 0, At, B0); PG8_MMA(0, 1, At, B1); PG8_BAR; PG8_SCHED;
            PG8_LDA(At, 0, 1); PG8_STAGE(PG8_SB(0, 0), b2, voffB); PG8_STAGE(PG8_SB(0, 1), b2 + hstep, voffB); PG8_STAGE(PG8_SA(0, 0), a2, voffA);
            PG8_WAIT_V(8); PG8_WAIT_L(0); PG8_BAR; PG8_MMA(1, 0, At, B0); PG8_MMA(1, 1, At, B1); PG8_BAR; PG8_SCHED;
            PG8_LDB(B0, 1, 0); PG8_LDB(B1, 1, 1); PG8_SCHED; PG8_LDA(At, 1, 0); PG8_STAGE(PG8_SA(0, 1), a2 + hstep, voffA);
            PG8_WAIT_V(8); PG8_WAIT_L(0); PG8_BAR; PG8_MMA(0, 0, At, B0); PG8_MMA(0, 1, At, B1); PG8_BAR; PG8_SCHED;
            PG8_LDA(At, 1, 1); PG8_STAGE(PG8_SB(1, 0), b3, voffB); PG8_STAGE(PG8_SB(1, 1), b3 + hstep, voffB); PG8_STAGE(PG8_SA(1, 0), a3, voffA);
            PG8_WAIT_V(8); PG8_WAIT_L(0); PG8_BAR; PG8_MMA(1, 0, At, B0); PG8_MMA(1, 1, At, B1); PG8_BAR; PG8_SCHED;
            } else {
            PG8_LDB(B0, 0, 0); PG8_SCHED; PG8_LDA(At, 0, 0); PG8_STAGE(PG8_SA(1, 1), a1 + hstep, voffA);
            PG8_WAIT_L(8); PG8_BAR; PG8_WAIT_L(0); PG8_MMA(0, 0, At, B0); PG8_BAR; PG8_SCHED;
            PG8_LDB(B1, 0, 1); PG8_STAGE(PG8_SB(0, 0), b2, voffB);
            PG8_BAR; PG8_WAIT_L(0); PG8_MMA(0, 1, At, B1); PG8_BAR;
            PG8_LDA(At, 0, 1); PG8_STAGE(PG8_SA(0, 0), a2, voffA);
            PG8_BAR; PG8_WAIT_L(0); PG8_MMA(1, 0, At, B0); PG8_BAR; PG8_SCHED;
            PG8_STAGE(PG8_SB(0, 1), b2 + hstep, voffB);
            PG8_WAIT_V(6); PG8_BAR; PG8_MMA(1, 1, At, B1); PG8_BAR;
            PG8_LDB(B0, 1, 0); PG8_SCHED; PG8_LDA(At, 1, 0); PG8_STAGE(PG8_SA(0, 1), a2 + hstep, voffA);
            PG8_WAIT_L(8); PG8_BAR; PG8_WAIT_L(0); PG8_MMA(0, 0, At, B0); PG8_BAR; PG8_SCHED;
            PG8_LDB(B1, 1, 1); PG8_STAGE(PG8_SB(1, 0), b3, voffB);
            PG8_BAR; PG8_WAIT_L(0); PG8_MMA(0, 1, At, B1); PG8_BAR;
            PG8_LDA(At, 1, 1); PG8_STAGE(PG8_SA(1, 0), a3, voffA);
            PG8_BAR; PG8_WAIT_L(0); PG8_MMA(1, 0, At, B0); PG8_BAR; PG8_SCHED;
            PG8_STAGE(PG8_SB(1, 1), b3 + hstep, voffB);
            PG8_WAIT_V(6); PG8_BAR; PG8_MMA(1, 1, At, B1); PG8_BAR;
            }
        }
        if constexpr (ALIGN_EPI) { if (wr == 0) PG8_BAR; }
        if constexpr (!Epi::AFTER_DRAIN) { int l2; asm volatile("v_mbcnt_lo_u32_b32 %0, -1, 0\n\tv_mbcnt_hi_u32_b32 %0, -1, %0" : "=v"(l2)); E(acc, cur, wr, wc, l2 & 15, l2 >> 4); S.done(cur); }
        if (!has_next) break;
#pragma unroll
        for (int a = 0; a < 2; ++a)
#pragma unroll
            for (int b = 0; b < 2; ++b)
#pragma unroll
                for (int m = 0; m < 4; ++m)
#pragma unroll
                    for (int n = 0; n < 2; ++n) acc[a][b][m][n] = (f32x4){0.f, 0.f, 0.f, 0.f};
        cur = nxt; cA = nA; cB = nB; ++ui;
        if constexpr (ALIGN_EPI) { if (wr == 1) PG8_BAR; }
    }
    PG8_WAIT_V(0);
    if constexpr (!ALIGN_EPI) { if (wr == 0) PG8_BAR; }
    PG8_BAR;
#undef PG8_SA
#undef PG8_SB
#undef PG8_STAGE
#undef PG8_LDA
#undef PG8_LDB
#undef PG8_MMA
#undef PG8_WAIT_V
#undef PG8_WAIT_L
#undef PG8_BAR
#undef PG8_SCHED
}
}

typedef f32x4 Acc[2][2][4][2];
#define EPI_ROWS_BEGIN \
    _Pragma("unroll") for (int ai = 0; ai < 2; ++ai) _Pragma("unroll") for (int m = 0; m < 4; ++m) { \
        const int r = u.pm * 256 + ai * 128 + wr * 64 + m * 16 + fr; if (r >= MV) continue;
#define EPI_ROWS_END asm volatile("" ::: "memory"); }

__device__ __forceinline__ float row_rstd(const float* SS, int r) {
    const f32x4* p = (const f32x4*)(SS + (size_t)r * 16); const f32x4 a = p[0], b = p[1], c = p[2], d = p[3];
    const float s = ((a.x + a.y) + (a.z + a.w)) + ((b.x + b.y) + (b.z + b.w)) + ((c.x + c.y) + (c.z + c.w)) + ((d.x + d.y) + (d.z + d.w));
    return rsqrtf(s * (1.0f / D) + EPS);
}

struct EpiIn {
    static constexpr bool PERM = true, AFTER_DRAIN = false;
    bf16_t* ACT; float* DT; bf16_t* VT; const float* SS; const float* BIAS; const float* dt_bias;
    __device__ __forceinline__ void operator()(const Acc& acc, const pg8::Unit& u, int wr, int wc, int fr, int fq) const {
        EPI_ROWS_BEGIN
            const int mb = mbof(r); const float rstd = row_rstd(SS, r);
#pragma unroll
            for (int bj = 0; bj < 2; ++bj) {
                const int colt = bj * 128 + wc * 32 + 8 * fq, c = u.pn * 256 + colt;
                const f32x4 b0 = *(const f32x4*)(BIAS + (size_t)mb * NINP + c), b1 = *(const f32x4*)(BIAS + (size_t)mb * NINP + c + 4);
                const f32x4 v0 = acc[ai][bj][m][0] * rstd + b0, v1 = acc[ai][bj][m][1] * rstd + b1;
                if (u.pn < 41) {
                    u32x4 w; w.x = cvt_pk_bf16(v0[0], v0[1]); w.y = cvt_pk_bf16(v0[2], v0[3]); w.z = cvt_pk_bf16(v1[0], v1[1]); w.w = cvt_pk_bf16(v1[2], v1[3]);
                    *(u32x4*)(ACT + (size_t)r * NINP + c) = w;
                    if (u.pn >= 6 && u.pn <= 8 && r < MP) {
                        const int g = u.pn - 6, sh = 2 * g  , b = r >> 13, t = r & (SEQ - 1);
                        const int pos = ((t & ((1 << sh) - 1)) << (13 - sh)) + (t >> sh);
                        const int hd = 4 * g + (colt >> 6), dd0 = colt & 63;
                        bf16_t* vt = VT + ((size_t)((b * 12 + hd) * 64 + dd0)) * SEQ + pos;
                        vt[0 * SEQ] = (bf16_t)(w.x & 0xffff); vt[1 * SEQ] = (bf16_t)(w.x >> 16); vt[2 * SEQ] = (bf16_t)(w.y & 0xffff); vt[3 * SEQ] = (bf16_t)(w.y >> 16);
                        vt[4 * SEQ] = (bf16_t)(w.z & 0xffff); vt[5 * SEQ] = (bf16_t)(w.z >> 16); vt[6 * SEQ] = (bf16_t)(w.w & 0xffff); vt[7 * SEQ] = (bf16_t)(w.w >> 16);
                    }
                } else if (colt < 32) {
                    f32x4 o0, o1;
#pragma unroll
                    for (int i = 0; i < 4; ++i) { o0[i] = softplusf_(v0[i] + dt_bias[colt + i]); o1[i] = softplusf_(v1[i] + dt_bias[colt + 4 + i]); }
                    *(f32x4*)(DT + (size_t)r * 32 + colt) = o0; *(f32x4*)(DT + (size_t)r * 32 + colt + 4) = o1;
                }
            }
        EPI_ROWS_END
    }
};

struct EpiT1 {
    static constexpr bool PERM = true, AFTER_DRAIN = false;
    const bf16_t* ACT; float* T1;
    __device__ __forceinline__ void operator()(const Acc& acc, const pg8::Unit& u, int wr, int wc, int fr, int fq) const {
        EPI_ROWS_BEGIN
#pragma unroll
            for (int bj = 0; bj < 2; ++bj) {
                const int c = u.pn * 256 + bj * 128 + wc * 32 + 8 * fq;
                const u32x4 gw = *(const u32x4*)(ACT + (size_t)r * NINP + CG + c);
                f32x4 o0, o1;
                o0[0] = sigmoidf_(blo(gw.x)) * acc[ai][bj][m][0][0]; o0[1] = sigmoidf_(bhi(gw.x)) * acc[ai][bj][m][0][1];
                o0[2] = sigmoidf_(blo(gw.y)) * acc[ai][bj][m][0][2]; o0[3] = sigmoidf_(bhi(gw.y)) * acc[ai][bj][m][0][3];
                o1[0] = sigmoidf_(blo(gw.z)) * acc[ai][bj][m][1][0]; o1[1] = sigmoidf_(bhi(gw.z)) * acc[ai][bj][m][1][1];
                o1[2] = sigmoidf_(blo(gw.w)) * acc[ai][bj][m][1][2]; o1[3] = sigmoidf_(bhi(gw.w)) * acc[ai][bj][m][1][3];
                *(f32x4*)(T1 + (size_t)r * D + c) = o0; *(f32x4*)(T1 + (size_t)r * D + c + 4) = o1;
                asm volatile("" ::: "memory");
            }
        EPI_ROWS_END
    }
};
struct EpiMerge {
    static constexpr bool PERM = true, AFTER_DRAIN = false;
    const bf16_t* ACT; const float* T1; bf16_t* MG;
    __device__ __forceinline__ void operator()(const Acc& acc, const pg8::Unit& u, int wr, int wc, int fr, int fq) const {
        EPI_ROWS_BEGIN
#pragma unroll
            for (int bj = 0; bj < 2; ++bj) {
                const int c = u.pn * 256 + bj * 128 + wc * 32 + 8 * fq;
                const u32x4 gw = *(const u32x4*)(ACT + (size_t)r * NINP + CG + 1024 + c);
                const f32x4 t0 = *(const f32x4*)(T1 + (size_t)r * D + c), t1 = *(const f32x4*)(T1 + (size_t)r * D + c + 4);
                f32x4 o0, o1;
                o0[0] = t0[0] + sigmoidf_(blo(gw.x)) * acc[ai][bj][m][0][0]; o0[1] = t0[1] + sigmoidf_(bhi(gw.x)) * acc[ai][bj][m][0][1];
                o0[2] = t0[2] + sigmoidf_(blo(gw.y)) * acc[ai][bj][m][0][2]; o0[3] = t0[3] + sigmoidf_(bhi(gw.y)) * acc[ai][bj][m][0][3];
                o1[0] = t1[0] + sigmoidf_(blo(gw.z)) * acc[ai][bj][m][1][0]; o1[1] = t1[1] + sigmoidf_(bhi(gw.z)) * acc[ai][bj][m][1][1];
                o1[2] = t1[2] + sigmoidf_(blo(gw.w)) * acc[ai][bj][m][1][2]; o1[3] = t1[3] + sigmoidf_(bhi(gw.w)) * acc[ai][bj][m][1][3];
                u32x4 w; w.x = cvt_pk_bf16(o0[0], o0[1]); w.y = cvt_pk_bf16(o0[2], o0[3]); w.z = cvt_pk_bf16(o1[0], o1[1]); w.w = cvt_pk_bf16(o1[2], o1[3]);
                *(u32x4*)(MG + (size_t)r * D + c) = w;
                asm volatile("" ::: "memory");
            }
        EPI_ROWS_END
    }
};
template <bool WRITE_XG> struct EpiRes {
    static constexpr bool PERM = true, AFTER_DRAIN = false;
    const float* xres_p; const float* xres_s;
    const float* gate;
    float* XO; float* SSO; bf16_t* XG; const float* normg; const float* sc;
    __device__ __forceinline__ void operator()(const Acc& acc, const pg8::Unit& u, int wr, int wc, int fr, int fq) const {
        EPI_ROWS_BEGIN
            const int mb = mbof(r);
            const float* xr = r < MP ? xres_p + (size_t)r * D : xres_s + (size_t)(r - MP) * D;
            float ss = 0.f;
#pragma unroll
            for (int bj = 0; bj < 2; ++bj) {
                const int c = u.pn * 256 + bj * 128 + wc * 32 + 8 * fq;
                const f32x4 x0 = *(const f32x4*)(xr + c), x1 = *(const f32x4*)(xr + c + 4);
                const f32x4 g0 = *(const f32x4*)(gate + (size_t)mb * 6144 + c), g1 = *(const f32x4*)(gate + (size_t)mb * 6144 + c + 4);
                const f32x4 o0 = x0 + g0 * acc[ai][bj][m][0], o1 = x1 + g1 * acc[ai][bj][m][1];
                *(f32x4*)(XO + (size_t)r * D + c) = o0; *(f32x4*)(XO + (size_t)r * D + c + 4) = o1;
                ss += (o0[0] * o0[0] + o0[1] * o0[1]) + (o0[2] * o0[2] + o0[3] * o0[3]) + (o1[0] * o1[0] + o1[1] * o1[1]) + (o1[2] * o1[2] + o1[3] * o1[3]);
                if (WRITE_XG) {
                    const f32x4 n0 = *(const f32x4*)(normg + c), n1 = *(const f32x4*)(normg + c + 4);
                    const f32x4 s0 = *(const f32x4*)(sc + (size_t)mb * 6144 + c), s1 = *(const f32x4*)(sc + (size_t)mb * 6144 + c + 4);
                    const f32x4 y0 = o0 * n0 * (s0 + 1.0f), y1 = o1 * n1 * (s1 + 1.0f);
                    u32x4 w; w.x = cvt_pk_bf16(y0[0], y0[1]); w.y = cvt_pk_bf16(y0[2], y0[3]); w.z = cvt_pk_bf16(y1[0], y1[1]); w.w = cvt_pk_bf16(y1[2], y1[3]);
                    *(u32x4*)(XG + (size_t)r * D + c) = w;
                }
            }
            ss += __shfl_xor(ss, 16); ss += __shfl_xor(ss, 32);
            if (fq == 0) SSO[(size_t)r * 16 + u.pn * 4 + wc] = ss;
        EPI_ROWS_END
    }
};
struct EpiUp {
    static constexpr bool PERM = true, AFTER_DRAIN = false;
    bf16_t* U; const float* SS; const float* BIAS;
    __device__ __forceinline__ void operator()(const Acc& acc, const pg8::Unit& u, int wr, int wc, int fr, int fq) const {
        EPI_ROWS_BEGIN
            const int mb = mbof(r); const float rstd = row_rstd(SS, r);
#pragma unroll
            for (int bj = 0; bj < 2; ++bj) {
                const int c = u.pn * 256 + bj * 128 + wc * 32 + 8 * fq;
                const f32x4 b0 = *(const f32x4*)(BIAS + (size_t)mb * DFF + c), b1 = *(const f32x4*)(BIAS + (size_t)mb * DFF + c + 4);
                f32x4 v0 = acc[ai][bj][m][0] * rstd + b0, v1 = acc[ai][bj][m][1] * rstd + b1;
#pragma unroll
                for (int i = 0; i < 4; ++i) { const float a = fmaxf(v0[i], 0.f), b = fmaxf(v1[i], 0.f); v0[i] = a * a; v1[i] = b * b; }
                u32x4 w; w.x = cvt_pk_bf16(v0[0], v0[1]); w.y = cvt_pk_bf16(v0[2], v0[3]); w.z = cvt_pk_bf16(v1[0], v1[1]); w.w = cvt_pk_bf16(v1[2], v1[3]);
                *(u32x4*)(U + (size_t)r * DFF + c) = w;
            }
        EPI_ROWS_END
    }
};

constexpr int NTHREADS = 512, NWAVES = 8;
constexpr int LDS_BYTES = 147456;
struct Args { const float* in[27]; float* out; unsigned char* ws; int ph_lo, ph_hi; };
static_assert(sizeof(Args) == 29 * 8 + 8, "no padding in Args");

struct Ctx {
    const Args& A; LAS unsigned char* lds; int tid, lane, wid, G, bid; float* out; unsigned char* ws;
    __device__ __forceinline__ const float* in(int k) const { return A.in[k]; }
};
__device__ __forceinline__ Ctx relaunder(const Ctx& X) {
    int w = X.wid, G = X.G, bid = X.bid; float* out = X.out; unsigned char* ws = X.ws; asm volatile("" : "+s"(w), "+s"(G), "+s"(bid));
    int ln; asm volatile("v_mbcnt_lo_u32_b32 %0, -1, 0\n\tv_mbcnt_hi_u32_b32 %0, -1, %0" : "=v"(ln));
    return Ctx{X.A, X.lds, w * 64 + ln, ln, w, G, bid, out, ws};
}
__device__ __forceinline__ const float* kvcache(const Ctx& X, int g) { return g == 0 ? X.in(2) : (g == 1 ? X.in(3) : X.in(4)); }
__device__ __forceinline__ size_t kvs_off(int g) { return g == 0 ? O_KVS0 : (g == 1 ? O_KVS1 : O_KVS2); }
__device__ __forceinline__ size_t kvp_off(int g) { return g == 0 ? O_KVP0 : (g == 1 ? O_KVP1 : O_KVP2); }
#define IN_X_P 0
#define IN_X_S 1
#define IN_KV0 2
#define IN_SSM 5
#define IN_CONV 6
#define IN_C_P 7
#define IN_C_S 8
#define IN_RELB 9
#define IN_WADA 10
#define IN_BADA 11
#define IN_N1G 12
#define IN_N2G 13
#define IN_WIN 14
#define IN_CONVW 15
#define IN_CONVB 16
#define IN_DTB 17
#define IN_ALOG 18
#define IN_DSKIP 19
#define IN_SSDG 20
#define IN_WOA 21
#define IN_WOS 22
#define IN_WOUT 23
#define IN_WUP 24
#define IN_WDN 25
#define IN_FING 26

template <bool SILU, class RowPtr>
__device__ __forceinline__ void skinny_item(const Ctx& X, RowPtr rp, const float* W, int ldw, int n0, int nvalid, const float* bvec, float* out, int ldo, int oc0) {
    LAS float* sl = (LAS float*)X.lds;
    float acc[NMB];
#pragma unroll
    for (int i = 0; i < NMB; ++i) acc[i] = 0.f;
    const bool valid = X.lane < nvalid;
    for (int half = 0; half < 2; ++half) {
        __syncthreads();
        for (int i = X.tid; i < NMB * 512; i += NTHREADS) { const int mb = i >> 9, kk = i & 511; float v = rp(mb)[half * 512 + kk]; if (SILU) v = siluf_(v); sl[i] = v; }
        __syncthreads();
        const int k0 = X.wid * 64;
#pragma unroll 4
        for (int kk = k0; kk < k0 + 64; ++kk) {
            const float w = valid ? W[(size_t)(half * 512 + kk) * ldw + n0 + X.lane] : 0.f;
#pragma unroll
            for (int mb = 0; mb < NMB; ++mb) acc[mb] += sl[mb * 512 + kk] * w;
        }
    }
    __syncthreads();
#pragma unroll
    for (int mb = 0; mb < NMB; ++mb) sl[(X.wid * NMB + mb) * 64 + X.lane] = acc[mb];
    __syncthreads();
    for (int o = X.tid; o < NMB * 64; o += NTHREADS) {
        const int mb = o >> 6, ln = o & 63; float s = 0.f;
#pragma unroll
        for (int w = 0; w < NWAVES; ++w) s += sl[(w * NMB + mb) * 64 + ln];
        if (ln < nvalid) out[(size_t)mb * ldo + oc0 + ln] = s + (bvec ? bvec[n0 + ln] : 0.f);
    }
    __syncthreads();
}

__device__ __forceinline__ void transpose_item(const float* W, int K, int N, bf16_t* WT, int k0, int n0, int drow0, LAS float* scr, int lane) {
#pragma unroll 8
    for (int i = 0; i < 32; ++i) { const int kk = 2 * i + (lane >> 5); scr[kk * 33 + (lane & 31)] = W[(size_t)(k0 + kk) * N + n0 + (lane & 31)]; }
    asm volatile("s_waitcnt lgkmcnt(0)" ::: "memory");
    const int c = lane & 7;
#pragma unroll
    for (int j = 0; j < 4; ++j) { const int n = (lane >> 3) + 8 * j; const LAS float* s = scr + (8 * c) * 33 + n;
        u32x4 o; o.x = cvt_pk_bf16(s[0 * 33], s[1 * 33]); o.y = cvt_pk_bf16(s[2 * 33], s[3 * 33]); o.z = cvt_pk_bf16(s[4 * 33], s[5 * 33]); o.w = cvt_pk_bf16(s[6 * 33], s[7 * 33]);
        *(u32x4*)(WT + (size_t)(drow0 + n) * K + k0 + 8 * c) = o; }
    asm volatile("s_waitcnt lgkmcnt(0)" ::: "memory");
}
__device__ __forceinline__ int win_dest_row(int n0) { return n0 < 8448 ? n0 : (n0 < 8480 ? CDT + (n0 - 8448) : n0 - 32); }

__device__ __forceinline__ int t5_bucket(int dist) {
    if (dist < 16) return dist;
    int large = 16 + (int)(logf((float)dist / 16.0f) / 4.852030263919617f * 16.0f);
    return large < 31 ? large : 31;
}

__device__ __forceinline__ void phase_p0a(const Ctx& X0) {
    const Ctx X = relaunder(X0);
    {
        const float* cp = X.in(IN_C_P); const float* cs = X.in(IN_C_S);
        auto rp = [=](int mb) { return mb < NBP ? cp + (size_t)mb * D : cs + (size_t)(mb - NBP) * D; };
        for (int it = X.bid; it < NLAYER * 96; it += X.G) {
            const int l = it / 96, cb = it % 96;
            skinny_item<true>(X, rp, X.in(IN_WADA) + (size_t)l * D * 6144, 6144, cb * 64, 64, X.in(IN_BADA) + (size_t)l * 6144,
                              (float*)(X.ws + WS_MOD) + (size_t)l * NMB * 6144, 6144, cb * 64);
        }
    }
    __syncthreads();
    {
        LAS float* scr = (LAS float*)(X.lds + X.wid * 8448);
        const int gw = X.bid * NWAVES + X.wid, NGW = X.G * NWAVES;
        constexpr int I_IN = 16 * 329, I_OA = 4 * 32, I_OS = 32 * 32, I_OUT = 16 * 32, I_UP = 16 * 128, I_DN = 64 * 32, I_L = I_IN + I_OA + I_OS + I_OUT + I_UP + I_DN;
        for (int it = gw; it < NLAYER * I_L; it += NGW) {
            const int l = it / I_L; int r = it % I_L;
            unsigned char* wl = X.ws + WS_W + (size_t)l * WL_SIZE;
            if (r < I_IN) { const int kb = r / 329, nb = r % 329; transpose_item(X.in(IN_WIN) + (size_t)l * D * NIN, D, NIN, (bf16_t*)(wl + WL_IN), kb * 64, nb * 32, win_dest_row(nb * 32), scr, X.lane); continue; } r -= I_IN;
            if (r < I_OA) { const int kb = r / 32, nb = r % 32; transpose_item(X.in(IN_WOA) + (size_t)l * 256 * D, 256, D, (bf16_t*)(wl + WL_OA), kb * 64, nb * 32, nb * 32, scr, X.lane); continue; } r -= I_OA;
            if (r < I_OS) { const int kb = r / 32, nb = r % 32; transpose_item(X.in(IN_WOS) + (size_t)l * DIN * D, DIN, D, (bf16_t*)(wl + WL_OS), kb * 64, nb * 32, nb * 32, scr, X.lane); continue; } r -= I_OS;
            if (r < I_OUT) { const int kb = r / 32, nb = r % 32; transpose_item(X.in(IN_WOUT) + (size_t)l * D * D, D, D, (bf16_t*)(wl + WL_OUT), kb * 64, nb * 32, nb * 32, scr, X.lane); continue; } r -= I_OUT;
            if (r < I_UP) { const int kb = r / 128, nb = r % 128; transpose_item(X.in(IN_WUP) + (size_t)l * D * DFF, D, DFF, (bf16_t*)(wl + WL_UP), kb * 64, nb * 32, nb * 32, scr, X.lane); continue; } r -= I_UP;
            { const int kb = r / 32, nb = r % 32; transpose_item(X.in(IN_WDN) + (size_t)l * DFF * D, DFF, D, (bf16_t*)(wl + WL_DN), kb * 64, nb * 32, nb * 32, scr, X.lane); }
        }
    }
    {
        const size_t gt = (size_t)X.bid * NTHREADS + X.tid, NT = (size_t)X.G * NTHREADS;
#pragma unroll
        for (int g = 0; g < 3; ++g) {
            const int Lb = 128 << (2 * g);
            const size_t nb4 = (size_t)(Lb - 1) * 128, blk4 = (size_t)Lb * 128, tot = 64 * nb4;
            const f32x4* src = (const f32x4*)kvcache(X, g); f32x4* dst = (f32x4*)(X.out + kvs_off(g));
            for (size_t i = gt; i < tot; i += NT) { const size_t blk = i / nb4, off = i - blk * nb4; dst[blk * blk4 + off] = src[blk * blk4 + 128 + off]; }
        }
    }
    if (X.bid == X.G - 1) {
        float* bt = (float*)(X.ws + WS_BTAB);
        for (int i = X.tid; i < 12 * 129; i += NTHREADS) { const int hd = i / 129, j = i % 129, g = hd >> 2; bt[hd * 132 + j] = X.in(IN_RELB)[t5_bucket(j << (2 * g)) * 12 + hd]; }
    }
}

__device__ __forceinline__ void phase_p0b(const Ctx& X0) {
    const Ctx X = relaunder(X0);
    const float* MOD = (const float*)(X.ws + WS_MOD);
    for (int it = X.bid; it < NLAYER * (168 + 64); it += X.G) {
        const int l = it / 232, r = it % 232;
        if (r < 168) {
            const int dc = r * 64; if (dc >= NIN) continue;
            const int sc = dc < 8448 ? dc : (dc < CDT ? dc + 32 : 8448 + (dc - CDT)); const int nv = dc < CDT ? 64 : 32;
            const float* mp = MOD + (size_t)l * NMB * 6144;
            auto rp = [=](int mb) { return mp + (size_t)mb * 6144; };
            skinny_item<false>(X, rp, X.in(IN_WIN) + (size_t)l * D * NIN, NIN, sc, nv, nullptr, (float*)(X.ws + WS_BIAS1) + (size_t)l * NMB * NINP, NINP, dc);
        } else {
            const int cb = r - 168;
            const float* mp = MOD + (size_t)l * NMB * 6144 + 3072;
            auto rp = [=](int mb) { return mp + (size_t)mb * 6144; };
            skinny_item<false>(X, rp, X.in(IN_WUP) + (size_t)l * D * DFF, DFF, cb * 64, 64, nullptr, (float*)(X.ws + WS_BIAS2) + (size_t)l * NMB * DFF, DFF, cb * 64);
        }
    }
    {
        const int gw = X.bid * NWAVES + X.wid, NGW = X.G * NWAVES;
        const float* ng = X.in(IN_N1G);
        for (int r = gw; r < MV; r += NGW) {
            const int mb = mbof(r);
            const float* xr = r < MP ? X.in(IN_X_P) + (size_t)r * D : X.in(IN_X_S) + (size_t)(r - MP) * D;
            const float* sc = MOD + (size_t)mb * 6144 + 1024;
            bf16_t* xo = (bf16_t*)(X.ws + WS_XG1) + (size_t)r * D;
            float ss = 0.f;
#pragma unroll
            for (int j = 0; j < 4; ++j) {
                const int c = 4 * X.lane + 256 * j;
                const f32x4 v = *(const f32x4*)(xr + c), g = *(const f32x4*)(ng + c), s = *(const f32x4*)(sc + c);
                ss += (v.x * v.x + v.y * v.y) + (v.z * v.z + v.w * v.w);
                const f32x4 y = v * g * (s + 1.0f);
                u32x2 w; w.x = cvt_pk_bf16(y.x, y.y); w.y = cvt_pk_bf16(y.z, y.w);
                *(u32x2*)(xo + c) = w;
            }
            ss = wave_sum(ss);
            if (X.lane < 16) ((float*)(X.ws + WS_SSA))[(size_t)r * 16 + X.lane] = X.lane == 0 ? ss : 0.f;
        }
    }
}

__device__ __forceinline__ void attn_microtile(const Ctx& X, int id, const LAS float* btab) {
    const bf16_t* ACT = (const bf16_t*)(X.ws + WS_ACT); const bf16_t* VT = (const bf16_t*)(X.ws + WS_VT);
    float* OG = (float*)(X.ws + WS_OG); float* LSE = (float*)(X.ws + WS_LSE);
    const int lane = X.lane, qi = lane & 15, kq = lane >> 4;
    int t = id; const int sub = t & 511; t >>= 9; const int hg = t & 3; t >>= 2; const int g = t % 3, b = t / 3;
    const int sh = 2 * g, ncl = 13 - sh;
    const int nsb = 1 << (ncl - 4);
    const int r = sub / nsb, s16 = sub % nsb;
    const int hd = 4 * g + hg, ilen = 1 << ncl;
    const int i0 = 16 * s16;
    const int tq = ((i0 + qi) << sh) + r;
    const size_t qrow = (size_t)(b * SEQ + tq) * NINP;
    bf16x8 qf[2];
#pragma unroll
    for (int ks = 0; ks < 2; ++ks) qf[ks] = *(const bf16x8*)(ACT + qrow + CQ + hd * 64 + 32 * ks + 8 * kq);
    f32x4 sc[10];
#pragma unroll
    for (int kt = 0; kt < 10; ++kt) {
        int ik = i0 - 128 + 16 * kt + qi; ik = ik < 0 ? 0 : (ik > ilen - 1 ? ilen - 1 : ik);
        const size_t krow = (size_t)(b * SEQ + (ik << sh) + r) * NINP + CK + hd * 64 + 8 * kq;
        const bf16x8 k0 = *(const bf16x8*)(ACT + krow), k1 = *(const bf16x8*)(ACT + krow + 32);
        f32x4 a = (f32x4){0.f, 0.f, 0.f, 0.f};
        a = MFMA16(k0, qf[0], a); a = MFMA16(k1, qf[1], a);
        sc[kt] = a;
    }
    float mx = -INFINITY;
#pragma unroll
    for (int kt = 0; kt < 10; ++kt)
#pragma unroll
        for (int e = 0; e < 4; ++e) {
            const int kk = 16 * kt + 4 * kq + e, j = 128 + qi - kk, ik = i0 - 128 + kk;
            const bool ok = (j >= 0) && (j <= 128) && (ik >= 0);
            const float s = ok ? sc[kt][e] * 0.125f + btab[hd * 132 + (ok ? j : 0)] : -INFINITY;
            sc[kt][e] = s; mx = fmaxf(mx, s);
        }
    mx = fmaxf(mx, __shfl_xor(mx, 16)); mx = fmaxf(mx, __shfl_xor(mx, 32));
    float l = 0.f;
#pragma unroll
    for (int kt = 0; kt < 10; ++kt)
#pragma unroll
        for (int e = 0; e < 4; ++e) { const float p = __expf(sc[kt][e] - mx); sc[kt][e] = p; l += p; }
    l += __shfl_xor(l, 16); l += __shfl_xor(l, 32);
    f32x4 o[4];
#pragma unroll
    for (int dt = 0; dt < 4; ++dt) o[dt] = (f32x4){0.f, 0.f, 0.f, 0.f};
    const bf16_t* vbase = VT + ((size_t)((b * 12 + hd) * 64 + qi)) * SEQ + (size_t)r * ilen;
#pragma unroll
    for (int ks2 = 0; ks2 < 5; ++ks2) {
        u32x4 pw; pw.x = cvt_pk_bf16(sc[2 * ks2][0], sc[2 * ks2][1]); pw.y = cvt_pk_bf16(sc[2 * ks2][2], sc[2 * ks2][3]);
        pw.z = cvt_pk_bf16(sc[2 * ks2 + 1][0], sc[2 * ks2 + 1][1]); pw.w = cvt_pk_bf16(sc[2 * ks2 + 1][2], sc[2 * ks2 + 1][3]);
        const bf16x8 pf = __builtin_bit_cast(bf16x8, pw);
        const int ia = i0 - 128 + 32 * ks2 + 4 * kq, ib = ia + 16;
        const bool oka = ia >= 0 && ia < ilen, okb = ib >= 0 && ib < ilen;
#pragma unroll
        for (int dt = 0; dt < 4; ++dt) {
            const bf16_t* vp = vbase + (size_t)(16 * dt) * SEQ;
            u32x2 va = (u32x2){0u, 0u}, vb = (u32x2){0u, 0u};
            if (oka) va = *(const u32x2*)(vp + ia);
            if (okb) vb = *(const u32x2*)(vp + ib);
            u32x4 vw; vw.x = va.x; vw.y = va.y; vw.z = vb.x; vw.w = vb.y;
            o[dt] = MFMA16(__builtin_bit_cast(bf16x8, vw), pf, o[dt]);
        }
    }
    const float inv = 1.0f / l;
    const size_t orow = (size_t)(b * SEQ + tq);
    float* op = OG + ((size_t)g * M + orow) * 256 + hg * 64 + 4 * kq;
#pragma unroll
    for (int dt = 0; dt < 4; ++dt) *(f32x4*)(op + 16 * dt) = o[dt] * inv;
    if (kq == 0) LSE[((size_t)g * M + orow) * 4 + hg] = mx + __logf(l);
}

constexpr int XS_RS = 144, BS_RS = 272;
constexpr int L_XS = 0, L_BS = L_XS + 128 * XS_RS, L_CS = L_BS + 128 * BS_RS, L_HB = L_CS + 128 * BS_RS, L_FL = L_HB + 64 * BS_RS;
static_assert(L_FL + 3 * 512 + 64 <= 131072, "ssd lds");

__device__ __forceinline__ void ssd_passA_item(const Ctx& X, int layer, int item) {
    const int S = item & (NSC - 1), h = (item >> 3) & 31, b = item >> 8, gi = h >> 2;
    const bf16_t* ACT = (const bf16_t*)(X.ws + WS_ACT); const float* DT = (const float*)(X.ws + WS_DT);
    float* YL = (float*)(X.ws + WS_YL); float* ACUM = (float*)(X.ws + WS_ACUM); bf16_t* CB = (bf16_t*)(X.ws + WS_CB);
    LAS unsigned char* lds = X.lds;
    LAS float* acs = (LAS float*)(lds + L_FL); LAS float* dtv = acs + 128; LAS float* wv = acs + 256; LAS float* misc = acs + 384;
    const int tid = X.tid, lane = X.lane, w = X.wid, l16 = lane & 15, kq = lane >> 4;
    const float A_h = -__expf(X.in(IN_ALOG)[layer * NH + h]), D_h = X.in(IN_DSKIP)[layer * NH + h];
    const int cc = tid % 40, rs = tid / 40; const bool stager = tid < 480;
    int ch0;
    int kind;
    if (cc < 8) { kind = 0; ch0 = h * 64 + cc * 8; } else if (cc < 24) { kind = 1; ch0 = 2048 + gi * 128 + (cc - 8) * 8; } else { kind = 2; ch0 = 3072 + gi * 128 + (cc - 24) * 8; }
    float cw[4][8], cbias[8];
    if (stager) {
        const float* cwp = X.in(IN_CONVW) + (size_t)layer * 4 * 4096; const float* cbp = X.in(IN_CONVB) + (size_t)layer * 4096;
#pragma unroll
        for (int i = 0; i < 8; ++i) { cbias[i] = cbp[ch0 + i];
#pragma unroll
            for (int t = 0; t < 4; ++t) cw[t][i] = cwp[t * 4096 + ch0 + i]; }
    }
    f32x4 Hacc[4];
#pragma unroll
    for (int pt = 0; pt < 4; ++pt) Hacc[pt] = (f32x4){0.f, 0.f, 0.f, 0.f};
    float abase = 0.f;
    __syncthreads();
    for (int c = 0; c < 8; ++c) {
        const int T0 = S * 1024 + c * 128; const size_t R0 = (size_t)b * SEQ + T0;
#pragma unroll
        for (int pt = 0; pt < 4; ++pt)
#pragma unroll
            for (int e = 0; e < 4; ++e) *(LAS bf16_t*)(lds + L_HB + (16 * pt + 4 * kq + e) * BS_RS + (16 * w + l16) * 2) = (bf16_t)f2bf(Hacc[pt][e]);
        if (stager) {
            const int r0 = rs * 11, r1 = r0 + 11 < 128 ? r0 + 11 : 128;
            const bf16_t* src = ACT + CX + ch0;
            float hist[3][8];
#pragma unroll
            for (int t = 0; t < 3; ++t) {
                const int tt = T0 + r0 - 3 + t;
                u32x4 v = (u32x4){0u, 0u, 0u, 0u};
                if (tt >= 0) v = *(const u32x4*)(src + ((size_t)b * SEQ + tt) * NINP);
                hist[t][0] = blo(v.x); hist[t][1] = bhi(v.x); hist[t][2] = blo(v.y); hist[t][3] = bhi(v.y); hist[t][4] = blo(v.z); hist[t][5] = bhi(v.z); hist[t][6] = blo(v.w); hist[t][7] = bhi(v.w);
            }
            LAS unsigned char* dst = kind == 0 ? lds + L_XS + (cc * 8) * 2 : (kind == 1 ? lds + L_BS + ((cc - 8) * 8) * 2 : lds + L_CS + ((cc - 24) * 8) * 2);
            const int rstride = kind == 0 ? XS_RS : BS_RS;
            for (int rr = r0; rr < r1; ++rr) {
                const u32x4 v = *(const u32x4*)(src + (R0 + rr) * NINP);
                float cur[8]; cur[0] = blo(v.x); cur[1] = bhi(v.x); cur[2] = blo(v.y); cur[3] = bhi(v.y); cur[4] = blo(v.z); cur[5] = bhi(v.z); cur[6] = blo(v.w); cur[7] = bhi(v.w);
                float y[8];
#pragma unroll
                for (int i = 0; i < 8; ++i) { y[i] = siluf_(cbias[i] + hist[0][i] * cw[0][i] + hist[1][i] * cw[1][i] + hist[2][i] * cw[2][i] + cur[i] * cw[3][i]);
                    hist[0][i] = hist[1][i]; hist[1][i] = hist[2][i]; hist[2][i] = cur[i]; }
                u32x4 o; o.x = cvt_pk_bf16(y[0], y[1]); o.y = cvt_pk_bf16(y[2], y[3]); o.z = cvt_pk_bf16(y[4], y[5]); o.w = cvt_pk_bf16(y[6], y[7]);
                *(LAS u32x4*)(dst + rr * rstride) = o;
                if (kind == 2 && (h & 3) == 0) *(u32x4*)(CB + (R0 + rr) * 1024 + gi * 128 + (cc - 24) * 8) = o;
            }
        }
        if (w == 0) {
            const float d0 = DT[(R0 + 2 * lane) * 32 + h], d1 = DT[(R0 + 2 * lane + 1) * 32 + h];
            const float a0 = d0 * A_h, a1 = d1 * A_h;
            float s = a0 + a1;
#pragma unroll
            for (int o = 1; o < 64; o <<= 1) { const float t = __shfl_up(s, o); if (lane >= o) s += t; }
            const float c1 = s, c0 = s - a1;
            const float tot = __shfl(s, 63);
            acs[2 * lane] = c0; acs[2 * lane + 1] = c1; dtv[2 * lane] = d0; dtv[2 * lane + 1] = d1;
            wv[2 * lane] = d0 * __expf(tot - c0); wv[2 * lane + 1] = d1 * __expf(tot - c1);
            ACUM[(R0 + 2 * lane) * 32 + h] = abase + c0; ACUM[(R0 + 2 * lane + 1) * 32 + h] = abase + c1;
            if (lane == 0) misc[0] = __expf(tot);
            abase += tot;
        }
        __syncthreads();
        const int lrow = 16 * w + l16;
        bf16x8 cf[4];
#pragma unroll
        for (int ks = 0; ks < 4; ++ks) cf[ks] = *(const LAS bf16x8*)(lds + L_CS + lrow * BS_RS + (32 * ks + 8 * kq) * 2);
        const float acl = acs[lrow];
        bf16x8 mf[4];
#pragma unroll
        for (int ks2 = 0; ks2 < 4; ++ks2) {
            unsigned pk[4];
#pragma unroll
            for (int hh = 0; hh < 2; ++hh) {
                const int st = 2 * ks2 + hh;
                f32x4 gacc = (f32x4){0.f, 0.f, 0.f, 0.f};
#pragma unroll
                for (int ks = 0; ks < 4; ++ks) { const bf16x8 bfr = *(const LAS bf16x8*)(lds + L_BS + (16 * st + l16) * BS_RS + (32 * ks + 8 * kq) * 2); gacc = MFMA16(bfr, cf[ks], gacc); }
                const f32x4 as4 = *(const LAS f32x4*)(acs + 16 * st + 4 * kq), dt4 = *(const LAS f32x4*)(dtv + 16 * st + 4 * kq);
                float mv[4];
#pragma unroll
                for (int e = 0; e < 4; ++e) { const int s = 16 * st + 4 * kq + e; const float arg = (s <= lrow) ? acl - as4[e] : -INFINITY; mv[e] = gacc[e] * __expf(arg) * dt4[e]; }
                pk[2 * hh] = cvt_pk_bf16(mv[0], mv[1]); pk[2 * hh + 1] = cvt_pk_bf16(mv[2], mv[3]);
            }
            u32x4 pw; pw.x = pk[0]; pw.y = pk[1]; pw.z = pk[2]; pw.w = pk[3];
            mf[ks2] = __builtin_bit_cast(bf16x8, pw);
        }
        f32x4 yd[4], yo[4];
#pragma unroll
        for (int pt = 0; pt < 4; ++pt) { yd[pt] = (f32x4){0.f, 0.f, 0.f, 0.f}; yo[pt] = (f32x4){0.f, 0.f, 0.f, 0.f}; }
        const int tq_ = l16 >> 2, tp_ = lane & 3;
#pragma unroll
        for (int ks2 = 0; ks2 < 4; ++ks2)
#pragma unroll
            for (int pt = 0; pt < 4; ++pt) {
                const LAS unsigned char* xa = lds + L_XS + (32 * ks2 + 4 * kq + tq_) * XS_RS + (16 * pt + 4 * tp_) * 2;
                const s16x4 lo = tr16(xa), hi = tr16(xa + 16 * XS_RS);
                const bf16x8 xf = (bf16x8){lo[0], lo[1], lo[2], lo[3], hi[0], hi[1], hi[2], hi[3]};
                yd[pt] = MFMA16(xf, mf[ks2], yd[pt]);
            }
#pragma unroll
        for (int ks = 0; ks < 4; ++ks)
#pragma unroll
            for (int pt = 0; pt < 4; ++pt) { const bf16x8 hf = *(const LAS bf16x8*)(lds + L_HB + (16 * pt + l16) * BS_RS + (32 * ks + 8 * kq) * 2); yo[pt] = MFMA16(hf, cf[ks], yo[pt]); }
        {
            const float eal = __expf(acl);
            float* yp = YL + (R0 + lrow) * DIN + h * 64 + 4 * kq;
#pragma unroll
            for (int pt = 0; pt < 4; ++pt) {
                const u32x2 xw = *(const LAS u32x2*)(lds + L_XS + lrow * XS_RS + (16 * pt + 4 * kq) * 2);
                f32x4 xv; xv[0] = blo(xw.x); xv[1] = bhi(xw.x); xv[2] = blo(xw.y); xv[3] = bhi(xw.y);
                *(f32x4*)(yp + 16 * pt) = yd[pt] + yo[pt] * eal + xv * D_h;
            }
        }
        {
            const float dec = misc[0];
#pragma unroll
            for (int pt = 0; pt < 4; ++pt) Hacc[pt] = Hacc[pt] * dec;
#pragma unroll
            for (int ks = 0; ks < 4; ++ks) {
                const int lr0 = 32 * ks + 8 * kq;
                const LAS unsigned char* ba = lds + L_BS + (lr0 + tq_) * BS_RS + (16 * w + 4 * tp_) * 2;
                const s16x4 blo_ = tr16(ba), bhi_ = tr16(ba + 4 * BS_RS);
                const bf16x8 bfr = (bf16x8){blo_[0], blo_[1], blo_[2], blo_[3], bhi_[0], bhi_[1], bhi_[2], bhi_[3]};
                const f32x4 w0 = *(const LAS f32x4*)(wv + lr0), w1 = *(const LAS f32x4*)(wv + lr0 + 4);
#pragma unroll
                for (int pt = 0; pt < 4; ++pt) {
                    const LAS unsigned char* xa = lds + L_XS + (lr0 + tq_) * XS_RS + (16 * pt + 4 * tp_) * 2;
                    const s16x4 lo = tr16(xa), hi = tr16(xa + 4 * XS_RS);
                    u32x4 xw;
                    xw.x = cvt_pk_bf16(bf2f((unsigned short)lo[0]) * w0[0], bf2f((unsigned short)lo[1]) * w0[1]); xw.y = cvt_pk_bf16(bf2f((unsigned short)lo[2]) * w0[2], bf2f((unsigned short)lo[3]) * w0[3]);
                    xw.z = cvt_pk_bf16(bf2f((unsigned short)hi[0]) * w1[0], bf2f((unsigned short)hi[1]) * w1[1]); xw.w = cvt_pk_bf16(bf2f((unsigned short)hi[2]) * w1[2], bf2f((unsigned short)hi[3]) * w1[3]);
                    Hacc[pt] = MFMA16(__builtin_bit_cast(bf16x8, xw), bfr, Hacc[pt]);
                }
            }
        }
        __syncthreads();
    }
    {
        float* hl = (float*)(X.ws + WS_HLOC) + ((size_t)((b * NH + h) * NSC + S)) * 8192;
#pragma unroll
        for (int pt = 0; pt < 4; ++pt)
#pragma unroll
            for (int e = 0; e < 4; ++e) hl[(16 * pt + 4 * kq + e) * 128 + 16 * w + l16] = Hacc[pt][e];
        if (w == 0 && lane == 0) ((float*)(X.ws + WS_ATOT))[(b * NH + h) * NSC + S] = abase;
    }
}

__device__ __forceinline__ void sample_attn_item(const Ctx& X, int layer, int item, const LAS float* btab) {
    const int b = item >> 2, hg = item & 3;
    const bf16_t* ACT = (const bf16_t*)(X.ws + WS_ACT);
    LAS float* sm = (LAS float*)(X.lds + 8192);
    const int lane = X.lane, w = X.wid;
    const size_t arow = (size_t)(MP + b) * NINP;
    __syncthreads();
    if (w < 3) {
        const int g = w, sh = 2 * g, Lb = 128 << sh, hd = 4 * g + hg;
        LAS float* q = sm + g * 320; LAS float* p = q + 64; LAS float* og = p + 136; LAS float* lse = og + 64;
        const float* cache = kvcache(X, g) + ((size_t)(layer * NBS + b) * Lb) * 512;
        const float knew = bf2f(ACT[arow + CK + hd * 64 + lane]), vnew = bf2f(ACT[arow + CV + hd * 64 + lane]);
        q[lane] = bf2f(ACT[arow + CQ + hd * 64 + lane]);
        { float* orow = X.out + kvs_off(g) + ((size_t)(layer * NBS + b) * Lb + (Lb - 1)) * 512;
          orow[hg * 64 + lane] = knew; orow[256 + hg * 64 + lane] = vnew; }
        float s[3];
        const float s0 = wave_sum(q[lane] * knew);
#pragma unroll
        for (int rnd = 0; rnd < 3; ++rnd) {
            const int j = rnd * 64 + lane; float acc = 0.f;
            if (j >= 1 && j <= 128) {
                const float* kr = cache + (size_t)(Lb - (j << sh)) * 512 + hg * 64;
#pragma unroll
                for (int d4 = 0; d4 < 16; ++d4) { const f32x4 kv = *(const f32x4*)(kr + 4 * d4); const f32x4 qv = *(const LAS f32x4*)(q + 4 * d4); acc += (kv.x * qv.x + kv.y * qv.y) + (kv.z * qv.z + kv.w * qv.w); }
            }
            if (j == 0) acc = s0;
            s[rnd] = (j <= 128) ? acc * 0.125f + btab[hd * 132 + (j <= 128 ? j : 0)] : -INFINITY;
        }
        const float mx = wave_max(fmaxf(fmaxf(s[0], s[1]), s[2]));
        float l = 0.f;
#pragma unroll
        for (int rnd = 0; rnd < 3; ++rnd) { const int j = rnd * 64 + lane; const float pv = __expf(s[rnd] - mx); if (j <= 128) { p[j] = pv; l += pv; } }
        l = wave_sum(l);
        asm volatile("s_waitcnt lgkmcnt(0)" ::: "memory");
        float o = p[0] * vnew;
        const float* vb = cache + 256 + hg * 64 + lane;
#pragma unroll 8
        for (int j = 1; j <= 128; ++j) o += p[j] * vb[(size_t)(Lb - (j << sh)) * 512];
        og[lane] = o / l;
        if (lane == 0) lse[0] = mx + __logf(l);
    }
    __syncthreads();
    if (w == 0) {
        const float l0 = sm[0 * 320 + 264], l1 = sm[1 * 320 + 264], l2 = sm[2 * 320 + 264];
        const float mm = fmaxf(l0, fmaxf(l1, l2)); const float e0 = __expf(l0 - mm), e1 = __expf(l1 - mm), e2 = __expf(l2 - mm); const float inv = 1.0f / (e0 + e1 + e2);
        const float v = (e0 * sm[0 * 320 + 200 + lane] + e1 * sm[1 * 320 + 200 + lane] + e2 * sm[2 * 320 + 200 + lane]) * inv;
        ((bf16_t*)(X.ws + WS_ATTN))[(size_t)(MP + b) * 256 + hg * 64 + lane] = (bf16_t)f2bf(v);
    }
}

__device__ __forceinline__ void sample_ssd_item(const Ctx& X, int layer, int item) {
    const int b = item >> 3, gi = item & 7;
    const bf16_t* ACT = (const bf16_t*)(X.ws + WS_ACT); const float* DT = (const float*)(X.ws + WS_DT);
    LAS float* xs = (LAS float*)(X.lds + 16384); LAS float* Bs = xs + 256; LAS float* Cs = Bs + 128; LAS float* ys = Cs + 128; LAS float* red = ys + 256;
    const int tid = X.tid, lane = X.lane, w = X.wid;
    const size_t arow = (size_t)(MP + b) * NINP;
    __syncthreads();
    {
        const int ch = tid < 256 ? gi * 256 + tid : (tid < 384 ? 2048 + gi * 128 + (tid - 256) : 3072 + gi * 128 + (tid - 384));
        const float* st = X.in(IN_CONV) + ((size_t)(layer * NBS + b) * 3) * 4096 + ch;
        const float* cwp = X.in(IN_CONVW) + (size_t)layer * 4 * 4096 + ch;
        const float s0 = st[0], s1 = st[4096], s2 = st[8192], xr = bf2f(ACT[arow + CX + ch]);
        const float y = siluf_(X.in(IN_CONVB)[layer * 4096 + ch] + s0 * cwp[0] + s1 * cwp[4096] + s2 * cwp[8192] + xr * cwp[12288]);
        xs[tid] = y;
        float* co = X.out + O_CONVS + ((size_t)(layer * NBS + b) * 3) * 4096 + ch;
        co[0] = s1; co[4096] = s2; co[8192] = xr;
    }
    __syncthreads();
    {
        const int e = w >> 1, h = gi * 4 + e, half = lane >> 5, n4 = (lane & 31) * 4;
        const float dt = DT[(size_t)(MP + b) * 32 + h], A_h = -__expf(X.in(IN_ALOG)[layer * NH + h]), D_h = X.in(IN_DSKIP)[layer * NH + h];
        const float dA = __expf(dt * A_h);
        const f32x4 Bv = *(const LAS f32x4*)(Bs + n4), Cv = *(const LAS f32x4*)(Cs + n4);
        const float* hin = X.in(IN_SSM) + ((size_t)((layer * NBS + b) * NH + h)) * 8192;
        float* hout = X.out + O_SSMS + ((size_t)((layer * NBS + b) * NH + h)) * 8192;
#pragma unroll 4
        for (int it = 0; it < 16; ++it) {
            const int p = 32 * (w & 1) + 2 * it + half;
            const float xp = xs[e * 64 + p];
            const f32x4 hv = *(const f32x4*)(hin + p * 128 + n4);
            const f32x4 hn = hv * dA + Bv * (dt * xp);
            *(f32x4*)(hout + p * 128 + n4) = hn;
            float y = (hn.x * Cv.x + hn.y * Cv.y) + (hn.z * Cv.z + hn.w * Cv.w);
            y += __shfl_xor(y, 1); y += __shfl_xor(y, 2); y += __shfl_xor(y, 4); y += __shfl_xor(y, 8); y += __shfl_xor(y, 16);
            if ((lane & 31) == 0) ys[e * 64 + p] = y + D_h * xp;
        }
    }
    __syncthreads();
    if (tid < 256) {
        const float z = bf2f(ACT[arow + CZ + gi * 256 + tid]);
        const float gv = ys[tid] * siluf_(z);
        float ss = wave_sum(gv * gv);
        if (lane == 0) red[w] = ss;
        ys[tid] = gv;
    }
    __syncthreads();
    if (tid < 256) {
        const float tot = red[0] + red[1] + red[2] + red[3];
        const float rstd = rsqrtf(tot * (1.0f / 256.0f) + EPS);
        ((bf16_t*)(X.ws + WS_SSDN))[(size_t)(MP + b) * DIN + gi * 256 + tid] = (bf16_t)f2bf(ys[tid] * rstd * X.in(IN_SSDG)[layer * DIN + gi * 256 + tid]);
    }
}

__device__ __forceinline__ void phase_p2(const Ctx& X0, int layer) {
    const Ctx X = relaunder(X0);
    LAS float* btab = (LAS float*)X.lds;
    __syncthreads();
    for (int i = X.tid; i < 12 * 132; i += NTHREADS) btab[i] = ((const float*)(X.ws + WS_BTAB))[i];
    __syncthreads();
#ifndef P2MASK
#define P2MASK 15
#endif
    if (P2MASK & 1) for (int it = X.bid; it < NBS * 4; it += X.G) sample_attn_item(X, layer, it, btab);
    if (P2MASK & 2) for (int it = X.bid; it < NBS * 8; it += X.G) sample_ssd_item(X, layer, it);
    if (P2MASK & 4) for (int bw = X.bid; bw < 1536; bw += X.G) attn_microtile(X, bw * 8 + X.wid, btab);
    __syncthreads();
    if (P2MASK & 8) for (int it = X.bid; it < NBP * NH * NSC; it += X.G) ssd_passA_item(X, layer, it);
}

constexpr int HIN_RS = 272;
__device__ __forceinline__ void passB_item(const Ctx& X, int layer, int item) {
    const int gi = item & 7, c = (item >> 3) & 63, b = item >> 9, S = c >> 3;
    const bf16_t* ACT = (const bf16_t*)(X.ws + WS_ACT); const bf16_t* CB = (const bf16_t*)(X.ws + WS_CB);
    const float* YL = (const float*)(X.ws + WS_YL); const float* ACUM = (const float*)(X.ws + WS_ACUM); const float* ATOT = (const float*)(X.ws + WS_ATOT);
    const float* HLOC = (const float*)(X.ws + WS_HLOC);
    LAS unsigned char* lds = X.lds;
    const int tid = X.tid, lane = X.lane, w = X.wid, l16 = lane & 15, kq = lane >> 4;
    __syncthreads();
    if (S > 0) {
#pragma unroll
        for (int e = 0; e < 4; ++e) {
            const int h = gi * 4 + e; const float* at = ATOT + (b * NH + h) * NSC; const float* hl = HLOC + ((size_t)(b * NH + h) * NSC) * 8192;
            f32x4 a[4];
#pragma unroll
            for (int i = 0; i < 4; ++i) a[i] = (f32x4){0.f, 0.f, 0.f, 0.f};
            float lg = 0.f;
            for (int sp = S - 1; sp >= 0; --sp) {
                const float wgt = __expf(lg);
                if (wgt == 0.f) break;
#pragma unroll
                for (int i = 0; i < 4; ++i) a[i] += *(const f32x4*)(hl + (size_t)sp * 8192 + (i * 512 + tid) * 4) * wgt;
                lg += at[sp];
            }
#pragma unroll
            for (int i = 0; i < 4; ++i) { const int idx = (i * 512 + tid) * 4, p = idx >> 7, n = idx & 127;
                u32x2 o; o.x = cvt_pk_bf16(a[i][0], a[i][1]); o.y = cvt_pk_bf16(a[i][2], a[i][3]);
                *(LAS u32x2*)(lds + (e * 64 + p) * HIN_RS + n * 2) = o; }
        }
    }
    __syncthreads();
    const size_t row = (size_t)b * SEQ + c * 128 + 16 * w + l16;
    f32x4 acc[4][4];
#pragma unroll
    for (int e = 0; e < 4; ++e)
#pragma unroll
        for (int pt = 0; pt < 4; ++pt) acc[e][pt] = (f32x4){0.f, 0.f, 0.f, 0.f};
    if (S > 0) {
#pragma unroll
        for (int ks = 0; ks < 4; ++ks) {
            const bf16x8 cf = *(const bf16x8*)(CB + row * 1024 + gi * 128 + 32 * ks + 8 * kq);
#pragma unroll
            for (int e = 0; e < 4; ++e)
#pragma unroll
                for (int pt = 0; pt < 4; ++pt) { const bf16x8 hf = *(const LAS bf16x8*)(lds + (e * 64 + 16 * pt + l16) * HIN_RS + (32 * ks + 8 * kq) * 2); acc[e][pt] = MFMA16(hf, cf, acc[e][pt]); }
        }
    }
    float ss = 0.f;
#pragma unroll
    for (int e = 0; e < 4; ++e) {
        const int h = gi * 4 + e; const float ea = S > 0 ? __expf(ACUM[row * 32 + h]) : 0.f;
#pragma unroll
        for (int pt = 0; pt < 4; ++pt) {
            const int col = h * 64 + 16 * pt + 4 * kq;
            const f32x4 yl = *(const f32x4*)(YL + row * DIN + col);
            const u32x2 zw = *(const u32x2*)(ACT + row * NINP + CZ + col);
            f32x4 y = yl + acc[e][pt] * ea;
            y[0] *= siluf_(blo(zw.x)); y[1] *= siluf_(bhi(zw.x)); y[2] *= siluf_(blo(zw.y)); y[3] *= siluf_(bhi(zw.y));
            ss += (y[0] * y[0] + y[1] * y[1]) + (y[2] * y[2] + y[3] * y[3]);
            acc[e][pt] = y;
        }
    }
    ss += __shfl_xor(ss, 16); ss += __shfl_xor(ss, 32);
    const float rstd = rsqrtf(ss * (1.0f / 256.0f) + EPS);
    const float* ng = X.in(IN_SSDG) + (size_t)layer * DIN;
    bf16_t* so = (bf16_t*)(X.ws + WS_SSDN) + row * DIN;
#pragma unroll
    for (int e = 0; e < 4; ++e)
#pragma unroll
        for (int pt = 0; pt < 4; ++pt) {
            const int col = (gi * 4 + e) * 64 + 16 * pt + 4 * kq;
            const f32x4 g = *(const f32x4*)(ng + col); const f32x4 y = acc[e][pt] * rstd * g;
            u32x2 o; o.x = cvt_pk_bf16(y[0], y[1]); o.y = cvt_pk_bf16(y[2], y[3]);
            *(u32x2*)(so + col) = o;
        }
}

__device__ __forceinline__ void phase_p3(const Ctx& X0, int layer) {
    const Ctx X = relaunder(X0);
    for (int it = X.bid; it < NBP * 64 * 8; it += X.G) passB_item(X, layer, it);
    {
        const float* ATOT = (const float*)(X.ws + WS_ATOT); const float* HLOC = (const float*)(X.ws + WS_HLOC);
        for (int it = X.bid; it < NBP * NH; it += X.G) {
            const float* at = ATOT + it * NSC; const float* hl = HLOC + (size_t)it * NSC * 8192;
            f32x4 a[4];
#pragma unroll
            for (int i = 0; i < 4; ++i) a[i] = (f32x4){0.f, 0.f, 0.f, 0.f};
            float lg = 0.f;
            for (int sp = NSC - 1; sp >= 0; --sp) {
                const float wgt = __expf(lg);
                if (wgt == 0.f) break;
#pragma unroll
                for (int i = 0; i < 4; ++i) a[i] += *(const f32x4*)(hl + (size_t)sp * 8192 + (i * 512 + X.tid) * 4) * wgt;
                lg += at[sp];
            }
            float* o = X.out + O_SSMP + ((size_t)layer * NBP * NH + it) * 8192;
#pragma unroll
            for (int i = 0; i < 4; ++i) *(f32x4*)(o + (i * 512 + X.tid) * 4) = a[i];
        }
    }
    const int gw = X.bid * NWAVES + X.wid, NGW = X.G * NWAVES, lane = X.lane;
    {
        const float* OG = (const float*)(X.ws + WS_OG); const float* LSE = (const float*)(X.ws + WS_LSE); bf16_t* AT = (bf16_t*)(X.ws + WS_ATTN);
        for (int row = gw; row < MP; row += NGW) {
            const int hg = lane >> 4;
            const float l0 = LSE[((size_t)0 * M + row) * 4 + hg], l1 = LSE[((size_t)1 * M + row) * 4 + hg], l2 = LSE[((size_t)2 * M + row) * 4 + hg];
            const float mm = fmaxf(l0, fmaxf(l1, l2)); const float e0 = __expf(l0 - mm), e1 = __expf(l1 - mm), e2 = __expf(l2 - mm); const float inv = 1.0f / (e0 + e1 + e2);
            const f32x4 a = *(const f32x4*)(OG + ((size_t)0 * M + row) * 256 + 4 * lane), bq = *(const f32x4*)(OG + ((size_t)1 * M + row) * 256 + 4 * lane), cq = *(const f32x4*)(OG + ((size_t)2 * M + row) * 256 + 4 * lane);
            const f32x4 v = (a * e0 + bq * e1 + cq * e2) * inv;
            u32x2 o; o.x = cvt_pk_bf16(v[0], v[1]); o.y = cvt_pk_bf16(v[2], v[3]);
            *(u32x2*)(AT + (size_t)row * 256 + 4 * lane) = o;
        }
    }
    {
        const bf16_t* ACT = (const bf16_t*)(X.ws + WS_ACT);
        for (int it = gw; it < 10752; it += NGW) {
            int g, r = it; if (r < 512) g = 0; else if (r < 2560) { g = 1; r -= 512; } else { g = 2; r -= 2560; }
            const int win = 128 << (2 * g), kv = r & 1, i = (r >> 1) % win, b = (r >> 1) / win;
            const size_t arow = ((size_t)b * SEQ + (SEQ - win + i)) * NINP + (kv ? CV : CK) + g * 256 + 4 * lane;
            const u32x2 v = *(const u32x2*)(ACT + arow);
            f32x4 o; o[0] = blo(v.x); o[1] = bhi(v.x); o[2] = blo(v.y); o[3] = bhi(v.y);
            *(f32x4*)(X.out + kvp_off(g) + ((((size_t)layer * NBP + b) * win + i) * 2 + kv) * 256 + 4 * lane) = o;
        }
        for (int it = gw; it < NBP * 3 * 16; it += NGW) {
            const int pc = it & 15, i = (it >> 4) % 3, b = it / 48;
            const u32x2 v = *(const u32x2*)(ACT + ((size_t)b * SEQ + SEQ - 3 + i) * NINP + CX + pc * 256 + 4 * lane);
            f32x4 o; o[0] = blo(v.x); o[1] = bhi(v.x); o[2] = blo(v.y); o[3] = bhi(v.y);
            *(f32x4*)(X.out + O_CONVP + (((size_t)layer * NBP + b) * 3 + i) * 4096 + pc * 256 + 4 * lane) = o;
        }
    }
}

__device__ __forceinline__ void phase_final(const Ctx& X0) {
    const Ctx X = relaunder(X0);
    const int gw = X.bid * NWAVES + X.wid, NGW = X.G * NWAVES, lane = X.lane;
    const float* XA = (const float*)(X.ws + WS_XA); const float* SS = (const float*)(X.ws + WS_SSA); const float* fg = X.in(IN_FING);
    for (int r = gw; r < MV; r += NGW) {
        const float rstd = row_rstd(SS, r);
        float* o = r < MP ? X.out + O_YP + (size_t)r * D : X.out + O_YS + (size_t)(r - MP) * D;
#pragma unroll
        for (int j = 0; j < 4; ++j) { const int c = 4 * lane + 256 * j; *(f32x4*)(o + c) = *(const f32x4*)(XA + (size_t)r * D + c) * rstd * *(const f32x4*)(fg + c); }
    }
}

constexpr int N_PHASES = 2 + 7 * NLAYER + 1;

__global__ void __launch_bounds__(NTHREADS, 2) fwd_megakernel(Args args) {
    extern __shared__ __attribute__((aligned(16))) unsigned char lds_raw[];
    const int wid_ = __builtin_amdgcn_readfirstlane((int)threadIdx.x >> 6);
    const Ctx X{args, (LAS unsigned char*)lds_raw, 0, 0, wid_, (int)gridDim.x, (int)blockIdx.x, args.out, args.ws};
    const int lo = args.ph_lo, hi = args.ph_hi;
#if MK_ONE_LAUNCH
    cg::grid_group grid = cg::this_grid();
#define SEAM() grid.sync()
#else
#define SEAM() do {} while (0)
#endif
#ifndef PHMASK
#define PHMASK 0xFFFFFFFFu
#endif
#define PHON(j) ((PHMASK >> (j)) & 1u)
#define IN(k) (lo <= (k) && (k) < hi)
#define SEAM_AFTER(k) do { if (IN(k) && IN((k) + 1)) SEAM(); } while (0)
    if (PHON(0) && IN(0)) { phase_p0a(X); } SEAM_AFTER(0);
    if (PHON(1) && IN(1)) { phase_p0b(X); } SEAM_AFTER(1);
    for (int l = 0; l < NLAYER; ++l) {
        const int pb = 2 + 7 * l;
        if (PHON(2) && IN(pb + 0)) {
            const Ctx Y = relaunder(X); unsigned char* ws = Y.ws; unsigned char* wl = ws + WS_W + (size_t)l * WL_SIZE; const float* MOD = (const float*)(ws + WS_MOD); (void)MOD;
            pg8::Gemm g{(const bf16_t*)(ws + WS_XG1), (const bf16_t*)(wl + WL_IN), M, NINP, D}; pg8::StaticOrder S; S.init(M, NINP, Y.G, Y.bid);
            EpiIn E{(bf16_t*)(ws + WS_ACT), (float*)(ws + WS_DT), (bf16_t*)(ws + WS_VT), (const float*)(ws + WS_SSA), (const float*)(ws + WS_BIAS1) + (size_t)l * NMB * NINP, args.in[IN_DTB] + l * NH};
            pg8::gemm_phase<EpiIn, pg8::StaticOrder, true, true>(Y.lds, g, S, E, Y.wid);
        }
        SEAM_AFTER(pb + 0);
        if (PHON(3) && IN(pb + 1)) phase_p2(X, l);
        SEAM_AFTER(pb + 1);
        if (PHON(4) && IN(pb + 2)) phase_p3(X, l);
        SEAM_AFTER(pb + 2);
        if (PHON(5) && IN(pb + 3)) {
            const Ctx Y = relaunder(X); unsigned char* ws = Y.ws; unsigned char* wl = ws + WS_W + (size_t)l * WL_SIZE; const float* MOD = (const float*)(ws + WS_MOD); (void)MOD; (void)wl;
#ifndef G4MASK
#define G4MASK 3
#endif
            if (G4MASK & 1) { pg8::Gemm g{(const bf16_t*)(ws + WS_ATTN), (const bf16_t*)(wl + WL_OA), M, D, 256}; pg8::StaticOrder S; S.init(M, D, Y.G, Y.bid);
              EpiT1 E{(const bf16_t*)(ws + WS_ACT), (float*)(ws + WS_T1)};
              pg8::gemm_phase<EpiT1, pg8::StaticOrder, true, true>(Y.lds, g, S, E, Y.wid); }
            if (G4MASK & 2) { pg8::Gemm g{(const bf16_t*)(ws + WS_SSDN), (const bf16_t*)(wl + WL_OS), M, D, DIN}; pg8::StaticOrder S; S.init(M, D, Y.G, Y.bid);
              EpiMerge E{(const bf16_t*)(ws + WS_ACT), (const float*)(ws + WS_T1), (bf16_t*)(ws + WS_MERGED)};
              pg8::gemm_phase<EpiMerge, pg8::StaticOrder, true, true>(Y.lds, g, S, E, Y.wid); }
        }
        SEAM_AFTER(pb + 3);
        if (PHON(6) && IN(pb + 4)) {
            const Ctx Y = relaunder(X); unsigned char* ws = Y.ws; unsigned char* wl = ws + WS_W + (size_t)l * WL_SIZE; const float* MOD = (const float*)(ws + WS_MOD); (void)MOD; (void)wl;
            pg8::Gemm g{(const bf16_t*)(ws + WS_MERGED), (const bf16_t*)(wl + WL_OUT), M, D, D}; pg8::StaticOrder S; S.init(M, D, Y.G, Y.bid);
            const float* xp = l == 0 ? args.in[IN_X_P] : (const float*)(ws + WS_XA); const float* xs = l == 0 ? args.in[IN_X_S] : (const float*)(ws + WS_XA) + (size_t)MP * D;
            EpiRes<true> E{xp, xs, MOD + (size_t)l * NMB * 6144 + 2048, (float*)(ws + WS_X1), (float*)(ws + WS_SSB), (bf16_t*)(ws + WS_XG2), args.in[IN_N2G] + (size_t)l * D, MOD + (size_t)l * NMB * 6144 + 4096};
            pg8::gemm_phase<EpiRes<true>, pg8::StaticOrder, true, true>(Y.lds, g, S, E, Y.wid);
        }
        SEAM_AFTER(pb + 4);
        if (PHON(7) && IN(pb + 5)) {
            const Ctx Y = relaunder(X); unsigned char* ws = Y.ws; unsigned char* wl = ws + WS_W + (size_t)l * WL_SIZE; const float* MOD = (const float*)(ws + WS_MOD); (void)MOD; (void)wl;
            pg8::Gemm g{(const bf16_t*)(ws + WS_XG2), (const bf16_t*)(wl + WL_UP), M, DFF, D}; pg8::StaticOrder S; S.init(M, DFF, Y.G, Y.bid);
            EpiUp E{(bf16_t*)(ws + WS_U), (const float*)(ws + WS_SSB), (const float*)(ws + WS_BIAS2) + (size_t)l * NMB * DFF};
            pg8::gemm_phase<EpiUp, pg8::StaticOrder, true, true>(Y.lds, g, S, E, Y.wid);
        }
        SEAM_AFTER(pb + 5);
        if (PHON(8) && IN(pb + 6)) {
            const Ctx Y = relaunder(X); unsigned char* ws = Y.ws; unsigned char* wl = ws + WS_W + (size_t)l * WL_SIZE; const float* MOD = (const float*)(ws + WS_MOD); (void)MOD; (void)wl;
            pg8::Gemm g{(const bf16_t*)(ws + WS_U), (const bf16_t*)(wl + WL_DN), M, D, DFF}; pg8::StaticOrder S; S.init(M, D, Y.G, Y.bid);
            const float* x1 = (const float*)(ws + WS_X1);
            if (l + 1 < NLAYER) {
                EpiRes<true> E{x1, x1 + (size_t)MP * D, MOD + (size_t)l * NMB * 6144 + 5120, (float*)(ws + WS_XA), (float*)(ws + WS_SSA), (bf16_t*)(ws + WS_XG1), args.in[IN_N1G] + (size_t)(l + 1) * D, MOD + (size_t)(l + 1) * NMB * 6144 + 1024};
                pg8::gemm_phase<EpiRes<true>, pg8::StaticOrder, true, true>(Y.lds, g, S, E, Y.wid);
            } else {
                EpiRes<false> E{x1, x1 + (size_t)MP * D, MOD + (size_t)l * NMB * 6144 + 5120, (float*)(ws + WS_XA), (float*)(ws + WS_SSA), nullptr, nullptr, nullptr};
                pg8::gemm_phase<EpiRes<false>, pg8::StaticOrder, true, true>(Y.lds, g, S, E, Y.wid);
            }
        }
        SEAM_AFTER(pb + 6);
    }
    if (PHON(9) && IN(N_PHASES - 1)) phase_final(X);
#undef IN
#undef SEAM_AFTER
#undef SEAM
}

extern "C" void kernel_launch(void* const* d_in, const int* in_sizes, int n_in, void* d_out, int out_size, void* d_ws, size_t ws_size, hipStream_t stream) {
    static int grid = 0;
    if (grid == 0) {
        if (n_in != 27 || (size_t)out_size != O_END || ws_size < WS_END) { fprintf(stderr, "kernel_launch: unexpected shapes: n_in %d out %d (want %zu) ws %zu (want %zu)\n", n_in, out_size, (size_t)O_END, ws_size, (size_t)WS_END); grid = -1; return; }
        int dev = 0, cus = 0, per_cu = 0;
        hipGetDevice(&dev); hipDeviceGetAttribute(&cus, hipDeviceAttributeMultiprocessorCount, dev);
        if (hipFuncSetAttribute((const void*)fwd_megakernel, hipFuncAttributeMaxDynamicSharedMemorySize, LDS_BYTES) != hipSuccess) { fprintf(stderr, "kernel_launch: hipFuncSetAttribute failed\n"); grid = -1; return; }
        if (hipOccupancyMaxActiveBlocksPerMultiprocessor(&per_cu, (const void*)fwd_megakernel, NTHREADS, LDS_BYTES) != hipSuccess || per_cu < 1) { fprintf(stderr, "kernel_launch: occupancy query says %d\n", per_cu); per_cu = 1; }
        (void)hipGetLastError();
        grid = cus;
    }
    if (grid < 0) return;
    Args a{};
    for (int i = 0; i < 27; ++i) a.in[i] = (const float*)d_in[i];
    a.out = (float*)d_out; a.ws = (unsigned char*)d_ws;
#if MK_ONE_LAUNCH
    a.ph_lo = 0; a.ph_hi = N_PHASES;
    void* kargs[] = {&a};
    hipError_t e = hipLaunchCooperativeKernel((const void*)fwd_megakernel, dim3(grid), dim3(NTHREADS), kargs, LDS_BYTES, stream);
    if (e != hipSuccess) fprintf(stderr, "cooperative launch failed: %s (grid %d)\n", hipGetErrorString(e), grid);
#else
    for (int p = 0; p < N_PHASES; ++p) { a.ph_lo = p; a.ph_hi = p + 1; hipLaunchKernelGGL(fwd_megakernel, dim3(grid), dim3(NTHREADS), LDS_BYTES, stream, a); }
#endif
}
```

```cpp
#include <hip/hip_runtime.h>
#include <hip/hip_cooperative_groups.h>
#include <cstdio>
#include <cstdint>
namespace cg = cooperative_groups;

#ifndef MK_ONE_LAUNCH
#define MK_ONE_LAUNCH 1
#endif

#define LAS __attribute__((address_space(3)))
typedef unsigned short bf16_t;
typedef short bf16x8 __attribute__((ext_vector_type(8)));
typedef short s16x4 __attribute__((ext_vector_type(4)));
typedef float f32x4 __attribute__((ext_vector_type(4)));
typedef float f32x2 __attribute__((ext_vector_type(2)));
typedef unsigned u32x4 __attribute__((ext_vector_type(4)));
typedef unsigned u32x2 __attribute__((ext_vector_type(2)));

constexpr int D = 1024, SEQ = 8192, NBP = 2, NBS = 32, MP = NBP * SEQ, MV = MP + NBS, M = MP + 256, NMB = NBP + NBS;
constexpr int NIN = 10528, NINP = 10752, DFF = 4096, DIN = 2048, NH = 32, NLAYER = 2;
constexpr int CQ = 0, CK = 768, CV = 1536, CZ = 2304, CX = 4352, CG = 8448, CDT = 10496;
constexpr float EPS = 1e-6f;
constexpr int NSC = 8;

constexpr size_t AL(size_t x) { return (x + 255) & ~(size_t)255; }
constexpr size_t WS_CTL = 0;
constexpr size_t WS_MOD = (size_t)1 << 20;
constexpr size_t WS_BIAS1 = WS_MOD + AL((size_t)NLAYER * NMB * 6144 * 4);
constexpr size_t WS_BIAS2 = WS_BIAS1 + AL((size_t)NLAYER * NMB * NINP * 4);
constexpr size_t WS_BTAB = WS_BIAS2 + AL((size_t)NLAYER * NMB * DFF * 4);
constexpr size_t WS_SSA = WS_BTAB + AL(12 * 132 * 4);
constexpr size_t WS_SSB = WS_SSA + AL((size_t)M * 16 * 4);
constexpr size_t WS_DT = WS_SSB + AL((size_t)M * 16 * 4);
constexpr size_t WS_ACUM = WS_DT + AL((size_t)M * 32 * 4);
constexpr size_t WS_ATOT = WS_ACUM + AL((size_t)M * 32 * 4);
constexpr size_t WS_LSE = WS_ATOT + AL(NBP * NH * NSC * 4);
constexpr size_t WS_HLOC = WS_LSE + AL((size_t)3 * M * 4 * 4);
constexpr size_t WS_W = WS_HLOC + AL((size_t)NBP * NH * NSC * 8192 * 4);
constexpr size_t WL_IN = 0, WL_OA = WL_IN + (size_t)NINP * D * 2, WL_OS = WL_OA + (size_t)D * 256 * 2, WL_OUT = WL_OS + (size_t)D * DIN * 2,
                 WL_UP = WL_OUT + (size_t)D * D * 2, WL_DN = WL_UP + (size_t)DFF * D * 2, WL_SIZE = WL_DN + (size_t)D * DFF * 2;
constexpr size_t WS_XG1 = WS_W + NLAYER * WL_SIZE;
constexpr size_t WS_XG2 = WS_XG1 + (size_t)M * D * 2;
constexpr size_t WS_X1 = WS_XG2 + (size_t)M * D * 2;
constexpr size_t WS_XA = WS_X1 + (size_t)M * D * 4;
constexpr size_t WS_ATTN = WS_XA + (size_t)M * D * 4;
constexpr size_t WS_SSDN = WS_ATTN + (size_t)M * 256 * 2;
constexpr size_t WS_VT = WS_SSDN + (size_t)M * DIN * 2;
constexpr size_t WS_CB = WS_VT + (size_t)NBP * 12 * 64 * SEQ * 2;
constexpr size_t WS_OG = WS_CB + (size_t)MP * 1024 * 2;
constexpr size_t WS_YL = WS_OG + (size_t)3 * M * 256 * 4;
constexpr size_t WS_T1 = WS_YL, WS_MERGED = WS_YL + (size_t)M * D * 4;
constexpr size_t WS_ACT = WS_YL + (size_t)M * DIN * 4;
constexpr size_t WS_U = WS_ACT;
constexpr size_t WS_END = WS_ACT + (size_t)M * NINP * 2;
static_assert(WS_MERGED + (size_t)M * D * 2 <= WS_ACT, "overlay");
static_assert(WS_END <= ((size_t)1 << 30), "workspace map must fit 1 GiB");

constexpr size_t O_YP = 0;
constexpr size_t O_YS = O_YP + (size_t)MP * D;
constexpr size_t O_KVP0 = O_YS + (size_t)NBS * D;
constexpr size_t O_KVP1 = O_KVP0 + (size_t)2 * 2 * 128 * 512;
constexpr size_t O_KVP2 = O_KVP1 + (size_t)2 * 2 * 512 * 512;
constexpr size_t O_SSMP = O_KVP2 + (size_t)2 * 2 * 2048 * 512;
constexpr size_t O_CONVP = O_SSMP + (size_t)2 * 2 * 32 * 8192;
constexpr size_t O_KVS0 = O_CONVP + (size_t)2 * 2 * 3 * 4096;
constexpr size_t O_KVS1 = O_KVS0 + (size_t)2 * 32 * 128 * 512;
constexpr size_t O_KVS2 = O_KVS1 + (size_t)2 * 32 * 512 * 512;
constexpr size_t O_SSMS = O_KVS2 + (size_t)2 * 32 * 2048 * 512;
constexpr size_t O_CONVS = O_SSMS + (size_t)2 * 32 * 32 * 8192;
constexpr size_t O_END = O_CONVS + (size_t)2 * 32 * 3 * 4096;

__device__ __forceinline__ float bf2f(unsigned h) { return __uint_as_float(h << 16); }
__device__ __forceinline__ unsigned f2bf(float f) { unsigned u = __float_as_uint(f); return (u + 0x7fffu + ((u >> 16) & 1u)) >> 16; }
__device__ __forceinline__ unsigned cvt_pk_bf16(float lo, float hi) { unsigned r; asm volatile("v_cvt_pk_bf16_f32 %0, %1, %2" : "=v"(r) : "v"(lo), "v"(hi)); return r; }
__device__ __forceinline__ float blo(unsigned w) { return __uint_as_float(w << 16); }
__device__ __forceinline__ float bhi(unsigned w) { return __uint_as_float(w & 0xffff0000u); }
__device__ __forceinline__ float sigmoidf_(float x) { return 1.0f / (1.0f + __expf(-x)); }
__device__ __forceinline__ float siluf_(float x) { return x / (1.0f + __expf(-x)); }
__device__ __forceinline__ float softplusf_(float x) { return fmaxf(x, 0.f) + log1pf(__expf(-fabsf(x))); }
__device__ __forceinline__ int mbof(int r) { return r < MP ? (r >> 13) : (r - MP + NBP < NMB ? r - MP + NBP : NMB - 1); }
__device__ __forceinline__ float wave_sum(float v) {
#pragma unroll
    for (int o = 1; o < 64; o <<= 1) v += __shfl_xor(v, o);
    return v;
}
__device__ __forceinline__ float wave_max(float v) {
#pragma unroll
    for (int o = 1; o < 64; o <<= 1) v = fmaxf(v, __shfl_xor(v, o));
    return v;
}
typedef short v4i16_t __attribute__((ext_vector_type(4)));
__device__ __forceinline__ s16x4 tr16(const LAS unsigned char* p) { return __builtin_bit_cast(s16x4, __builtin_amdgcn_ds_read_tr16_b64_v4i16((LAS v4i16_t*)p)); }
#define MFMA16(a, b, c) __builtin_amdgcn_mfma_f32_16x16x32_bf16((a), (b), (c), 0, 0, 0)

namespace pg8 {
constexpr int BM = 256, BK = 64, HALF = 128, HTB = HALF * BK * 2, STAGE_BYTES = 8 * HTB, NXCD = 8, WGM = 8;
__host__ __device__ __forceinline__ int lds_byte(int r, int c) { const int st = (r >> 4) * 2 + (c >> 5), rr = r & 15, cc = c & 31, ob = rr * 64 + cc * 2; return st * 1024 + (ob ^ (((ob >> 9) & 1) << 5)); }
__host__ __device__ __forceinline__ void stage_rc(int b, int& R, int& C) { const int st = b / 1024, sb = b % 1024, swz = sb ^ (((sb >> 9) & 1) << 5); R = (st >> 1) * 16 + swz / 64; C = (st & 1) * 32 + (swz % 64) / 2; }
__host__ __device__ __forceinline__ int perm32(int rho) { const int n = rho >> 4, i = rho & 15; return 8 * (i >> 2) + 4 * n + (i & 3); }
struct Unit { int pm, pn; };
struct Gemm { const bf16_t* A; const bf16_t* Bt; int M, N, K; };
struct StaticOrder {
    int nM, nN, nwg, G, c;
    __host__ __device__ void init(int M_, int N_, int G_, int c_) { nM = M_ / BM; nN = N_ / BM; nwg = nM * nN; G = G_; c = c_; }
    __host__ __device__ bool next(int i, Unit& u) const {
        const long L = (long)i * G + c; if (L >= nwg) return false;
        int wgid = (int)L; { const int q = nwg / NXCD, r = nwg % NXCD, xcd = wgid % NXCD, off = wgid / NXCD; wgid = (xcd < r ? xcd * (q + 1) : r * (q + 1) + (xcd - r) * q) + off; }
        const int nig = WGM * nN, gid = wgid / nig, fm = gid * WGM, gsz = (nM - fm) < WGM ? (nM - fm) : WGM;
        u.pm = fm + ((wgid % nig) % gsz); u.pn = (wgid % nig) / gsz; return true;
    }
    __device__ __forceinline__ void a_ready(const Unit&) const {}
    __device__ __forceinline__ void done(const Unit&) const {}
};

template <class Epi, class Sched, bool ALIGN_EPI = false, bool SP2 = false>
__device__ __forceinline__ void gemm_phase(LAS unsigned char* lds, const Gemm g, const Sched& S, const Epi& E, int wid_in) {
    int wid = wid_in; asm volatile("" : "+s"(wid));
    int lane; asm volatile("v_mbcnt_lo_u32_b32 %0, -1, 0\n\tv_mbcnt_hi_u32_b32 %0, -1, %0" : "=v"(lane));
    const int tid = wid * 64 + lane, wr = wid >> 2, wc = wid & 3, fr = lane & 15, fq = lane >> 4;
    const int K = g.K, nt = K / BK;
    unsigned voffA[2], voffB[2];
#pragma unroll
    for (int i = 0; i < 2; ++i) { int R, C; stage_rc(tid * 16 + i * 8192, R, C); const int Rb = Epi::PERM ? ((R & ~31) + perm32(R & 31)) : R;
        voffA[i] = (unsigned)(R * K + C) * 2u; voffB[i] = (unsigned)(Rb * K + C) * 2u; }
    const size_t kstep = (size_t)(BK * 2);
    const size_t hstep = (size_t)HALF * K * 2;
    const size_t tstep = 2 * hstep;
    const unsigned ldsw = (unsigned)wid * 1024u;
    const int aoff = lds_byte(wr * 64 + fr, fq * 8), boff = lds_byte(wc * 32 + fr, fq * 8);
#define PG8_SA(b, h) (((b) * 2 + (h)) * HTB)
#define PG8_SB(b, h) ((4 + (b) * 2 + (h)) * HTB)
#define PG8_STAGE(bufoff, gbase, voff) do { _Pragma("unroll") for (int _i = 0; _i < 2; ++_i) \
        __builtin_amdgcn_global_load_lds((const unsigned*)((const char*)(gbase) + (voff)[_i]), (LAS unsigned*)(lds + (bufoff) + ldsw + _i * 8192), 16, 0, 0); } while (0)
#define PG8_LDA(dst, b, h) do { _Pragma("unroll") for (int m = 0; m < 4; ++m) _Pragma("unroll") for (int k = 0; k < 2; ++k) dst[m][k] = *(const LAS bf16x8*)(lds + PG8_SA(b, h) + aoff + m * 2048 + k * 1024); } while (0)
#define PG8_LDB(dst, b, h) do { _Pragma("unroll") for (int n = 0; n < 2; ++n) _Pragma("unroll") for (int k = 0; k < 2; ++k) dst[n][k] = *(const LAS bf16x8*)(lds + PG8_SB(b, h) + boff + n * 2048 + k * 1024); } while (0)
#define PG8_MMA(ai, bj, At, Bt) do { __builtin_amdgcn_s_setprio(1); _Pragma("unroll") for (int m = 0; m < 4; ++m) _Pragma("unroll") for (int n = 0; n < 2; ++n) _Pragma("unroll") for (int k = 0; k < 2; ++k) \
        acc[ai][bj][m][n] = __builtin_amdgcn_mfma_f32_16x16x32_bf16(Bt[n][k], At[m][k], acc[ai][bj][m][n], 0, 0, 0); __builtin_amdgcn_s_setprio(0); } while (0)
#define PG8_WAIT_V(n) asm volatile("s_waitcnt vmcnt(" #n ")" ::: "memory")
#define PG8_WAIT_L(n) asm volatile("s_waitcnt lgkmcnt(" #n ")" ::: "memory")
#define PG8_BAR __builtin_amdgcn_s_barrier()
#define PG8_SCHED __builtin_amdgcn_sched_barrier(0)
    Unit cur, nxt; int ui = 0;
    if (!S.next(0, cur)) return;
    f32x4 acc[2][2][4][2];
#pragma unroll
    for (int a = 0; a < 2; ++a)
#pragma unroll
        for (int b = 0; b < 2; ++b)
#pragma unroll
            for (int m = 0; m < 4; ++m)
#pragma unroll
                for (int n = 0; n < 2; ++n) acc[a][b][m][n] = (f32x4){0.f, 0.f, 0.f, 0.f};
    bf16x8 At[4][2], B0[2][2], B1[2][2];
    const char* cA = (const char*)g.A + (size_t)cur.pm * tstep; const char* cB = (const char*)g.Bt + (size_t)cur.pn * tstep;
    S.a_ready(cur);
    if constexpr (SP2) {
        PG8_STAGE(PG8_SB(0, 0), cB, voffB); PG8_STAGE(PG8_SB(0, 1), cB + hstep, voffB); PG8_STAGE(PG8_SA(0, 0), cA, voffA); PG8_STAGE(PG8_SA(0, 1), cA + hstep, voffA);
        if (wr == 1) PG8_BAR;
        PG8_WAIT_V(2); PG8_BAR;
        PG8_STAGE(PG8_SB(1, 0), cB + kstep, voffB); PG8_STAGE(PG8_SA(1, 0), cA + kstep, voffA); PG8_STAGE(PG8_SB(1, 1), cB + hstep + kstep, voffB);
        PG8_WAIT_V(6); PG8_BAR;
    } else {
        PG8_STAGE(PG8_SB(0, 0), cB, voffB); PG8_STAGE(PG8_SA(0, 0), cA, voffA); PG8_STAGE(PG8_SB(0, 1), cB + hstep, voffB); PG8_STAGE(PG8_SA(0, 1), cA + hstep, voffA);
        if (wr == 1) PG8_BAR;
        PG8_WAIT_V(4); PG8_BAR;
        PG8_STAGE(PG8_SB(1, 0), cB + kstep, voffB); PG8_STAGE(PG8_SA(1, 0), cA + kstep, voffA); PG8_STAGE(PG8_SB(1, 1), cB + hstep + kstep, voffB);
        PG8_WAIT_V(6); PG8_BAR;
    }
    for (;;) {
        const bool has_next = S.next(ui + 1, nxt);
        const char* nA = has_next ? (const char*)g.A + (size_t)nxt.pm * tstep : cA; const char* nB = has_next ? (const char*)g.Bt + (size_t)nxt.pn * tstep : cB;
#pragma unroll 1
        for (int t = 0; t < nt; t += 2) {
            const bool last = (t == nt - 2);
            const char* a1 = cA + (size_t)(t + 1) * kstep;
            const char* a2 = last ? nA : cA + (size_t)(t + 2) * kstep; const char* b2 = last ? nB : cB + (size_t)(t + 2) * kstep;
            const char* a3 = a2 + kstep; const char* b3 = b2 + kstep;
            if (last && has_next) S.a_ready(nxt);
            if constexpr (SP2) {
            PG8_LDB(B0, 0, 0); PG8_LDB(B1, 0, 1); PG8_SCHED; PG8_LDA(At, 0, 0); PG8_STAGE(PG8_SA(1, 1), a1 + hstep, voffA);
            PG8_WAIT_V(8); PG8_WAIT_L(0); PG8_BAR; PG8_MMA(0, 0, At, B0); PG8_MMA(0, 1, At, B1); PG8_BAR; PG8_SCHED;
            PG8_LDA(At, 0, 1); PG8_STAGE(PG8_SB(0, 0), b2, voffB); PG8_STAGE(PG8_SB(0, 1), b2 + hstep, voffB); PG8_STAGE(PG8_SA(0, 0), a2, voffA);
            PG8_WAIT_V(8); PG8_WAIT_L(0); PG8_BAR; PG8_MMA(1, 0, At, B0); PG8_MMA(1, 1, At, B1); PG8_BAR; PG8_SCHED;
            PG8_LDB(B0, 1, 0); PG8_LDB(B1, 1, 1); PG8_SCHED; PG8_LDA(At, 1, 0); PG8_STAGE(PG8_SA(0, 1), a2 + hstep, voffA);
            PG8_WAIT_V(8); PG8_WAIT_L(0); PG8_BAR; PG8_MMA(0, 0, At, B0); PG8_MMA(0, 1, At, B1); PG8_BAR; PG8_SCHED;
            PG8_LDA(At, 1, 1); PG8_STAGE(PG8_SB(1, 0), b3, voffB); PG8_STAGE(PG8_SB(1, 1), b3 + hstep, voffB); PG8_STAGE(PG8_SA(1, 0), a3, voffA);
            PG8_WAIT_V(8); PG8_WAIT_L(0); PG8_BAR; PG8_MMA(1, 0, At, B0); PG8_MMA(1, 1, At, B1); PG8_BAR; PG8_SCHED;
            } else {
            PG8_LDB(B0, 0, 0); PG8_SCHED; PG8_LDA(At, 0, 0); PG8_STAGE(PG8_SA(1, 1), a1 + hstep, voffA);
            PG8_WAIT_L(8); PG8_BAR; PG8_WAIT_L(0); PG8_MMA(0, 0, At, B0); PG8_BAR; PG8_SCHED;
            PG8_LDB(B1, 0, 1); PG8_STAGE(PG8_SB(0, 0), b2, voffB);
            PG8_BAR; PG8_WAIT_L(0); PG8_MMA(0, 1, At, B1); PG8_BAR;
            PG8_LDA(At, 0, 1); PG8_STAGE(PG8_SA(0, 0), a2, voffA);
            PG8_BAR; PG8_WAIT_L(0); PG8_MMA(1, 0, At, B0); PG8_BAR; PG8_SCHED;
            PG8_STAGE(PG8_SB(0, 1), b2 + hstep, voffB);
            PG8_WAIT_V(6); PG8_BAR; PG8_MMA(1, 1, At, B1); PG8_BAR;
            PG8_LDB(B0, 1, 0); PG8_SCHED; PG8_LDA(At, 1, 0); PG8_STAGE(PG8_SA(0, 1), a2 + hstep, voffA);
            PG8_WAIT_L(8); PG8_BAR; PG8_WAIT_L(0); PG8_MMA(0, 0, At, B0); PG8_BAR; PG8_SCHED;
            PG8_LDB(B1, 1, 1); PG8_STAGE(PG8_SB(1, 0), b3, voffB);
            PG8_BAR; PG8_WAIT_L(0); PG8_MMA(0, 1, At, B1); PG8_BAR;
            PG8_LDA(At, 1, 1); PG8_STAGE(PG8_SA(1, 0), a3, voffA);
            PG8_BAR; PG8_WAIT_L(0); PG8_MMA(1, 0, At, B0); PG8_BAR; PG8_SCHED;
            PG8_STAGE(PG8_SB(1, 1), b3 + hstep, voffB);
            PG8_WAIT_V(6); PG8_BAR; PG8_MMA(1, 1, At, B1); PG8_BAR;
            }
        }
        if constexpr (ALIGN_EPI) { if (wr == 0) PG8_BAR; }
        if constexpr (!Epi::AFTER_DRAIN) { int l2; asm volatile("v_mbcnt_lo_u32_b32 %0, -1, 0\n\tv_mbcnt_hi_u32_b32 %0, -1, %0" : "=v"(l2)); E(acc, cur, wr, wc, l2 & 15, l2 >> 4); S.done(cur); }
        if (!has_next) break;
#pragma unroll
        for (int a = 0; a < 2; ++a)
#pragma unroll
            for (int b = 0; b < 2; ++b)
#pragma unroll
                for (int m = 0; m < 4; ++m)
#pragma unroll
                    for (int n = 0; n < 2; ++n) acc[a][b][m][n] = (f32x4){0.f, 0.f, 0.f, 0.f};
        cur = nxt; cA = nA; cB = nB; ++ui;
        if constexpr (ALIGN_EPI) { if (wr == 1) PG8_BAR; }
    }
    PG8_WAIT_V(0);
    if constexpr (!ALIGN_EPI) { if (wr == 0) PG8_BAR; }
    PG8_BAR;
#undef PG8_SA
#undef PG8_SB
#undef PG8_STAGE
#undef PG8_LDA
#undef PG8_LDB
#undef PG8_MMA
#undef PG8_WAIT_V
#undef PG8_WAIT_L
#undef PG8_BAR
#undef PG8_SCHED
}
}

typedef f32x4 Acc[2][2][4][2];
#define EPI_ROWS_BEGIN \
    _Pragma("unroll") for (int ai = 0; ai < 2; ++ai) _Pragma("unroll") for (int m = 0; m < 4; ++m) { \
        const int r = u.pm * 256 + ai * 128 + wr * 64 + m * 16 + fr; if (r >= MV) continue;
#define EPI_ROWS_END asm volatile("" ::: "memory"); }

__device__ __forceinline__ float row_rstd(const float* SS, int r) {
    const f32x4* p = (const f32x4*)(SS + (size_t)r * 16); const f32x4 a = p[0], b = p[1], c = p[2], d = p[3];
    const float s = ((a.x + a.y) + (a.z + a.w)) + ((b.x + b.y) + (b.z + b.w)) + ((c.x + c.y) + (c.z + c.w)) + ((d.x + d.y) + (d.z + d.w));
    return rsqrtf(s * (1.0f / D) + EPS);
}

struct EpiIn {
    static constexpr bool PERM = true, AFTER_DRAIN = false;
    bf16_t* ACT; float* DT; bf16_t* VT; const float* SS; const float* BIAS; const float* dt_bias;
    __device__ __forceinline__ void operator()(const Acc& acc, const pg8::Unit& u, int wr, int wc, int fr, int fq) const {
        EPI_ROWS_BEGIN
            const int mb = mbof(r); const float rstd = row_rstd(SS, r);
#pragma unroll
            for (int bj = 0; bj < 2; ++bj) {
                const int colt = bj * 128 + wc * 32 + 8 * fq, c = u.pn * 256 + colt;
                const f32x4 b0 = *(const f32x4*)(BIAS + (size_t)mb * NINP + c), b1 = *(const f32x4*)(BIAS + (size_t)mb * NINP + c + 4);
                const f32x4 v0 = acc[ai][bj][m][0] * rstd + b0, v1 = acc[ai][bj][m][1] * rstd + b1;
                if (u.pn < 41) {
                    u32x4 w; w.x = cvt_pk_bf16(v0[0], v0[1]); w.y = cvt_pk_bf16(v0[2], v0[3]); w.z = cvt_pk_bf16(v1[0], v1[1]); w.w = cvt_pk_bf16(v1[2], v1[3]);
                    *(u32x4*)(ACT + (size_t)r * NINP + c) = w;
                    if (u.pn >= 6 && u.pn <= 8 && r < MP) {
                        const int g = u.pn - 6, sh = 2 * g  , b = r >> 13, t = r & (SEQ - 1);
                        const int pos = ((t & ((1 << sh) - 1)) << (13 - sh)) + (t >> sh);
                        const int hd = 4 * g + (colt >> 6), dd0 = colt & 63;
                        bf16_t* vt = VT + ((size_t)((b * 12 + hd) * 64 + dd0)) * SEQ + pos;
                        vt[0 * SEQ] = (bf16_t)(w.x & 0xffff); vt[1 * SEQ] = (bf16_t)(w.x >> 16); vt[2 * SEQ] = (bf16_t)(w.y & 0xffff); vt[3 * SEQ] = (bf16_t)(w.y >> 16);
                        vt[4 * SEQ] = (bf16_t)(w.z & 0xffff); vt[5 * SEQ] = (bf16_t)(w.z >> 16); vt[6 * SEQ] = (bf16_t)(w.w & 0xffff); vt[7 * SEQ] = (bf16_t)(w.w >> 16);
                    }
                } else if (colt < 32) {
                    f32x4 o0, o1;
#pragma unroll
                    for (int i = 0; i < 4; ++i) { o0[i] = softplusf_(v0[i] + dt_bias[colt + i]); o1[i] = softplusf_(v1[i] + dt_bias[colt + 4 + i]); }
                    *(f32x4*)(DT + (size_t)r * 32 + colt) = o0; *(f32x4*)(DT + (size_t)r * 32 + colt + 4) = o1;
                }
            }
        EPI_ROWS_END
    }
};

struct EpiT1 {
    static constexpr bool PERM = true, AFTER_DRAIN = false;
    const bf16_t* ACT; float* T1;
    __device__ __forceinline__ void operator()(const Acc& acc, const pg8::Unit& u, int wr, int wc, int fr, int fq) const {
        EPI_ROWS_BEGIN
#pragma unroll
            for (int bj = 0; bj < 2; ++bj) {
                const int c = u.pn * 256 + bj * 128 + wc * 32 + 8 * fq;
                const u32x4 gw = *(const u32x4*)(ACT + (size_t)r * NINP + CG + c);
                f32x4 o0, o1;
                o0[0] = sigmoidf_(blo(gw.x)) * acc[ai][bj][m][0][0]; o0[1] = sigmoidf_(bhi(gw.x)) * acc[ai][bj][m][0][1];
                o0[2] = sigmoidf_(blo(gw.y)) * acc[ai][bj][m][0][2]; o0[3] = sigmoidf_(bhi(gw.y)) * acc[ai][bj][m][0][3];
                o1[0] = sigmoidf_(blo(gw.z)) * acc[ai][bj][m][1][0]; o1[1] = sigmoidf_(bhi(gw.z)) * acc[ai][bj][m][1][1];
                o1[2] = sigmoidf_(blo(gw.w)) * acc[ai][bj][m][1][2]; o1[3] = sigmoidf_(bhi(gw.w)) * acc[ai][bj][m][1][3];
                *(f32x4*)(T1 + (size_t)r * D + c) = o0; *(f32x4*)(T1 + (size_t)r * D + c + 4) = o1;
                asm volatile("" ::: "memory");
            }
        EPI_ROWS_END
    }
};
struct EpiMerge {
    static constexpr bool PERM = true, AFTER_DRAIN = false;
    const bf16_t* ACT; const float* T1; bf16_t* MG;
    __device__ __forceinline__ void operator()(const Acc& acc, const pg8::Unit& u, int wr, int wc, int fr, int fq) const {
        EPI_ROWS_BEGIN
#pragma unroll
            for (int bj = 0; bj < 2; ++bj) {
                const int c = u.pn * 256 + bj * 128 + wc * 32 + 8 * fq;
                const u32x4 gw = *(const u32x4*)(ACT + (size_t)r * NINP + CG + 1024 + c);
                const f32x4 t0 = *(const f32x4*)(T1 + (size_t)r * D + c), t1 = *(const f32x4*)(T1 + (size_t)r * D + c + 4);
                f32x4 o0, o1;
                o0[0] = t0[0] + sigmoidf_(blo(gw.x)) * acc[ai][bj][m][0][0]; o0[1] = t0[1] + sigmoidf_(bhi(gw.x)) * acc[ai][bj][m][0][1];
                o0[2] = t0[2] + sigmoidf_(blo(gw.y)) * acc[ai][bj][m][0][2]; o0[3] = t0[3] + sigmoidf_(bhi(gw.y)) * acc[ai][bj][m][0][3];
                o1[0] = t1[0] + sigmoidf_(blo(gw.z)) * acc[ai][bj][m][1][0]; o1[1] = t1[1] + sigmoidf_(bhi(gw.z)) * acc[ai][bj][m][1][1];
                o1[2] = t1[2] + sigmoidf_(blo(gw.w)) * acc[ai][bj][m][1][2]; o1[3] = t1[3] + sigmoidf_(bhi(gw.w)) * acc[ai][bj][m][1][3];
                u32x4 w; w.x = cvt_pk_bf16(o0[0], o0[1]); w.y = cvt_pk_bf16(o0[2], o0[3]); w.z = cvt_pk_bf16(o1[0], o1[1]); w.w = cvt_pk_bf16(o1[2], o1[3]);
                *(u32x4*)(MG + (size_t)r * D + c) = w;
                asm volatile("" ::: "memory");
            }
        EPI_ROWS_END
    }
};
template <bool WRITE_XG> struct EpiRes {
    static constexpr bool PERM = true, AFTER_DRAIN = false;
    const float* xres_p; const float* xres_s;
    const float* gate;
    float* XO; float* SSO; bf16_t* XG; const float* normg; const float* sc;
    __device__ __forceinline__ void operator()(const Acc& acc, const pg8::Unit& u, int wr, int wc, int fr, int fq) const {
        EPI_ROWS_BEGIN
            const int mb = mbof(r);
            const float* xr = r < MP ? xres_p + (size_t)r * D : xres_s + (size_t)(r - MP) * D;
            float ss = 0.f;
#pragma unroll
            for (int bj = 0; bj < 2; ++bj) {
                const int c = u.pn * 256 + bj * 128 + wc * 32 + 8 * fq;
                const f32x4 x0 = *(const f32x4*)(xr + c), x1 = *(const f32x4*)(xr + c + 4);
                const f32x4 g0 = *(const f32x4*)(gate + (size_t)mb * 6144 + c), g1 = *(const f32x4*)(gate + (size_t)mb * 6144 + c + 4);
                const f32x4 o0 = x0 + g0 * acc[ai][bj][m][0], o1 = x1 + g1 * acc[ai][bj][m][1];
                *(f32x4*)(XO + (size_t)r * D + c) = o0; *(f32x4*)(XO + (size_t)r * D + c + 4) = o1;
                ss += (o0[0] * o0[0] + o0[1] * o0[1]) + (o0[2] * o0[2] + o0[3] * o0[3]) + (o1[0] * o1[0] + o1[1] * o1[1]) + (o1[2] * o1[2] + o1[3] * o1[3]);
                if (WRITE_XG) {
                    const f32x4 n0 = *(const f32x4*)(normg + c), n1 = *(const f32x4*)(normg + c + 4);
                    const f32x4 s0 = *(const f32x4*)(sc + (size_t)mb * 6144 + c), s1 = *(const f32x4*)(sc + (size_t)mb * 6144 + c + 4);
                    const f32x4 y0 = o0 * n0 * (s0 + 1.0f), y1 = o1 * n1 * (s1 + 1.0f);
                    u32x4 w; w.x = cvt_pk_bf16(y0[0], y0[1]); w.y = cvt_pk_bf16(y0[2], y0[3]); w.z = cvt_pk_bf16(y1[0], y1[1]); w.w = cvt_pk_bf16(y1[2], y1[3]);
                    *(u32x4*)(XG + (size_t)r * D + c) = w;
                }
            }
            ss += __shfl_xor(ss, 16); ss += __shfl_xor(ss, 32);
            if (fq == 0) SSO[(size_t)r * 16 + u.pn * 4 + wc] = ss;
        EPI_ROWS_END
    }
};
struct EpiUp {
    static constexpr bool PERM = true, AFTER_DRAIN = false;
    bf16_t* U; const float* SS; const float* BIAS;
    __device__ __forceinline__ void operator()(const Acc& acc, const pg8::Unit& u, int wr, int wc, int fr, int fq) const {
        EPI_ROWS_BEGIN
            const int mb = mbof(r); const float rstd = row_rstd(SS, r);
#pragma unroll
            for (int bj = 0; bj < 2; ++bj) {
                const int c = u.pn * 256 + bj * 128 + wc * 32 + 8 * fq;
                const f32x4 b0 = *(const f32x4*)(BIAS + (size_t)mb * DFF + c), b1 = *(const f32x4*)(BIAS + (size_t)mb * DFF + c + 4);
                f32x4 v0 = acc[ai][bj][m][0] * rstd + b0, v1 = acc[ai][bj][m][1] * rstd + b1;
#pragma unroll
                for (int i = 0; i < 4; ++i) { const float a = fmaxf(v0[i], 0.f), b = fmaxf(v1[i], 0.f); v0[i] = a * a; v1[i] = b * b; }
                u32x4 w; w.x = cvt_pk_bf16(v0[0], v0[1]); w.y = cvt_pk_bf16(v0[2], v0[3]); w.z = cvt_pk_bf16(v1[0], v1[1]); w.w = cvt_pk_bf16(v1[2], v1[3]);
                *(u32x4*)(U + (size_t)r * DFF + c) = w;
            }
        EPI_ROWS_END
    }
};

constexpr int NTHREADS = 512, NWAVES = 8;
constexpr int LDS_BYTES = 147456;
struct Args { const float* in[27]; float* out; unsigned char* ws; int ph_lo, ph_hi; };
static_assert(sizeof(Args) == 29 * 8 + 8, "no padding in Args");

struct Ctx {
    const Args& A; LAS unsigned char* lds; int tid, lane, wid, G, bid; float* out; unsigned char* ws;
    __device__ __forceinline__ const float* in(int k) const { return A.in[k]; }
};
__device__ __forceinline__ Ctx relaunder(const Ctx& X) {
    int w = X.wid, G = X.G, bid = X.bid; float* out = X.out; unsigned char* ws = X.ws; asm volatile("" : "+s"(w), "+s"(G), "+s"(bid));
    int ln; asm volatile("v_mbcnt_lo_u32_b32 %0, -1, 0\n\tv_mbcnt_hi_u32_b32 %0, -1, %0" : "=v"(ln));
    return Ctx{X.A, X.lds, w * 64 + ln, ln, w, G, bid, out, ws};
}
__device__ __forceinline__ const float* kvcache(const Ctx& X, int g) { return g == 0 ? X.in(2) : (g == 1 ? X.in(3) : X.in(4)); }
__device__ __forceinline__ size_t kvs_off(int g) { return g == 0 ? O_KVS0 : (g == 1 ? O_KVS1 : O_KVS2); }
__device__ __forceinline__ size_t kvp_off(int g) { return g == 0 ? O_KVP0 : (g == 1 ? O_KVP1 : O_KVP2); }
#define IN_X_P 0
#define IN_X_S 1
#define IN_KV0 2
#define IN_SSM 5
#define IN_CONV 6
#define IN_C_P 7
#define IN_C_S 8
#define IN_RELB 9
#define IN_WADA 10
#define IN_BADA 11
#define IN_N1G 12
#define IN_N2G 13
#define IN_WIN 14
#define IN_CONVW 15
#define IN_CONVB 16
#define IN_DTB 17
#define IN_ALOG 18
#define IN_DSKIP 19
#define IN_SSDG 20
#define IN_WOA 21
#define IN_WOS 22
#define IN_WOUT 23
#define IN_WUP 24
#define IN_WDN 25
#define IN_FING 26

template <bool SILU, class RowPtr>
__device__ __forceinline__ void skinny_item(const Ctx& X, RowPtr rp, const float* W, int ldw, int n0, int nvalid, const float* bvec, float* out, int ldo, int oc0) {
    LAS float* sl = (LAS float*)X.lds;
    float acc[NMB];
#pragma unroll
    for (int i = 0; i < NMB; ++i) acc[i] = 0.f;
    const bool valid = X.lane < nvalid;
    for (int half = 0; half < 2; ++half) {
        __syncthreads();
        for (int i = X.tid; i < NMB * 512; i += NTHREADS) { const int mb = i >> 9, kk = i & 511; float v = rp(mb)[half * 512 + kk]; if (SILU) v = siluf_(v); sl[i] = v; }
        __syncthreads();
        const int k0 = X.wid * 64;
#pragma unroll 4
        for (int kk = k0; kk < k0 + 64; ++kk) {
            const float w = valid ? W[(size_t)(half * 512 + kk) * ldw + n0 + X.lane] : 0.f;
#pragma unroll
            for (int mb = 0; mb < NMB; ++mb) acc[mb] += sl[mb * 512 + kk] * w;
        }
    }
    __syncthreads();
#pragma unroll
    for (int mb = 0; mb < NMB; ++mb) sl[(X.wid * NMB + mb) * 64 + X.lane] = acc[mb];
    __syncthreads();
    for (int o = X.tid; o < NMB * 64; o += NTHREADS) {
        const int mb = o >> 6, ln = o & 63; float s = 0.f;
#pragma unroll
        for (int w = 0; w < NWAVES; ++w) s += sl[(w * NMB + mb) * 64 + ln];
        if (ln < nvalid) out[(size_t)mb * ldo + oc0 + ln] = s + (bvec ? bvec[n0 + ln] : 0.f);
    }
    __syncthreads();
}

__device__ __forceinline__ void transpose_item(const float* W, int K, int N, bf16_t* WT, int k0, int n0, int drow0, LAS float* scr, int lane) {
#pragma unroll 8
    for (int i = 0; i < 32; ++i) { const int kk = 2 * i + (lane >> 5); scr[kk * 33 + (lane & 31)] = W[(size_t)(k0 + kk) * N + n0 + (lane & 31)]; }
    asm volatile("s_waitcnt lgkmcnt(0)" ::: "memory");
    const int c = lane & 7;
#pragma unroll
    for (int j = 0; j < 4; ++j) { const int n = (lane >> 3) + 8 * j; const LAS float* s = scr + (8 * c) * 33 + n;
        u32x4 o; o.x = cvt_pk_bf16(s[0 * 33], s[1 * 33]); o.y = cvt_pk_bf16(s[2 * 33], s[3 * 33]); o.z = cvt_pk_bf16(s[4 * 33], s[5 * 33]); o.w = cvt_pk_bf16(s[6 * 33], s[7 * 33]);
        *(u32x4*)(WT + (size_t)(drow0 + n) * K + k0 + 8 * c) = o; }
    asm volatile("s_waitcnt lgkmcnt(0)" ::: "memory");
}
__device__ __forceinline__ int win_dest_row(int n0) { return n0 < 8448 ? n0 : (n0 < 8480 ? CDT + (n0 - 8448) : n0 - 32); }

__device__ __forceinline__ int t5_bucket(int dist) {
    if (dist < 16) return dist;
    int large = 16 + (int)(logf((float)dist / 16.0f) / 4.852030263919617f * 16.0f);
    return large < 31 ? large : 31;
}

__device__ __forceinline__ void phase_p0a(const Ctx& X0) {
    const Ctx X = relaunder(X0);
    {
        const float* cp = X.in(IN_C_P); const float* cs = X.in(IN_C_S);
        auto rp = [=](int mb) { return mb < NBP ? cp + (size_t)mb * D : cs + (size_t)(mb - NBP) * D; };
        for (int it = X.bid; it < NLAYER * 96; it += X.G) {
            const int l = it / 96, cb = it % 96;
            skinny_item<true>(X, rp, X.in(IN_WADA) + (size_t)l * D * 6144, 6144, cb * 64, 64, X.in(IN_BADA) + (size_t)l * 6144,
                              (float*)(X.ws + WS_MOD) + (size_t)l * NMB * 6144, 6144, cb * 64);
        }
    }
    __syncthreads();
    {
        LAS float* scr = (LAS float*)(X.lds + X.wid * 8448);
        const int gw = X.bid * NWAVES + X.wid, NGW = X.G * NWAVES;
        constexpr int I_IN = 16 * 329, I_OA = 4 * 32, I_OS = 32 * 32, I_OUT = 16 * 32, I_UP = 16 * 128, I_DN = 64 * 32, I_L = I_IN + I_OA + I_OS + I_OUT + I_UP + I_DN;
        for (int it = gw; it < NLAYER * I_L; it += NGW) {
            const int l = it / I_L; int r = it % I_L;
            unsigned char* wl = X.ws + WS_W + (size_t)l * WL_SIZE;
            if (r < I_IN) { const int kb = r / 329, nb = r % 329; transpose_item(X.in(IN_WIN) + (size_t)l * D * NIN, D, NIN, (bf16_t*)(wl + WL_IN), kb * 64, nb * 32, win_dest_row(nb * 32), scr, X.lane); continue; } r -= I_IN;
            if (r < I_OA) { const int kb = r / 32, nb = r % 32; transpose_item(X.in(IN_WOA) + (size_t)l * 256 * D, 256, D, (bf16_t*)(wl + WL_OA), kb * 64, nb * 32, nb * 32, scr, X.lane); continue; } r -= I_OA;
            if (r < I_OS) { const int kb = r / 32, nb = r % 32; transpose_item(X.in(IN_WOS) + (size_t)l * DIN * D, DIN, D, (bf16_t*)(wl + WL_OS), kb * 64, nb * 32, nb * 32, scr, X.lane); continue; } r -= I_OS;
            if (r < I_OUT) { const int kb = r / 32, nb = r % 32; transpose_item(X.in(IN_WOUT) + (size_t)l * D * D, D, D, (bf16_t*)(wl + WL_OUT), kb * 64, nb * 32, nb * 32, scr, X.lane); continue; } r -= I_OUT;
            if (r < I_UP) { const int kb = r / 128, nb = r % 128; transpose_item(X.in(IN_WUP) + (size_t)l * D * DFF, D, DFF, (bf16_t*)(wl + WL_UP), kb * 64, nb * 32, nb * 32, scr, X.lane); continue; } r -= I_UP;
            { const int kb = r / 32, nb = r % 32; transpose_item(X.in(IN_WDN) + (size_t)l * DFF * D, DFF, D, (bf16_t*)(wl + WL_DN), kb * 64, nb * 32, nb * 32, scr, X.lane); }
        }
    }
    {
        const size_t gt = (size_t)X.bid * NTHREADS + X.tid, NT = (size_t)X.G * NTHREADS;
#pragma unroll
        for (int g = 0; g < 3; ++g) {
            const int Lb = 128 << (2 * g);
            const size_t nb4 = (size_t)(Lb - 1) * 128, blk4 = (size_t)Lb * 128, tot = 64 * nb4;
            const f32x4* src = (const f32x4*)kvcache(X, g); f32x4* dst = (f32x4*)(X.out + kvs_off(g));
            for (size_t i = gt; i < tot; i += NT) { const size_t blk = i / nb4, off = i - blk * nb4; dst[blk * blk4 + off] = src[blk * blk4 + 128 + off]; }
        }
    }
    if (X.bid == X.G - 1) {
        float* bt = (float*)(X.ws + WS_BTAB);
        for (int i = X.tid; i < 12 * 129; i += NTHREADS) { const int hd = i / 129, j = i % 129, g = hd >> 2; bt[hd * 132 + j] = X.in(IN_RELB)[t5_bucket(j << (2 * g)) * 12 + hd]; }
    }
}

__device__ __forceinline__ void phase_p0b(const Ctx& X0) {
    const Ctx X = relaunder(X0);
    const float* MOD = (const float*)(X.ws + WS_MOD);
    for (int it = X.bid; it < NLAYER * (168 + 64); it += X.G) {
        const int l = it / 232, r = it % 232;
        if (r < 168) {
            const int dc = r * 64; if (dc >= NIN) continue;
            const int sc = dc < 8448 ? dc : (dc < CDT ? dc + 32 : 8448 + (dc - CDT)); const int nv = dc < CDT ? 64 : 32;
            const float* mp = MOD + (size_t)l * NMB * 6144;
            auto rp = [=](int mb) { return mp + (size_t)mb * 6144; };
            skinny_item<false>(X, rp, X.in(IN_WIN) + (size_t)l * D * NIN, NIN, sc, nv, nullptr, (float*)(X.ws + WS_BIAS1) + (size_t)l * NMB * NINP, NINP, dc);
        } else {
            const int cb = r - 168;
            const float* mp = MOD + (size_t)l * NMB * 6144 + 3072;
            auto rp = [=](int mb) { return mp + (size_t)mb * 6144; };
            skinny_item<false>(X, rp, X.in(IN_WUP) + (size_t)l * D * DFF, DFF, cb * 64, 64, nullptr, (float*)(X.ws + WS_BIAS2) + (size_t)l * NMB * DFF, DFF, cb * 64);
        }
    }
    {
        const int gw = X.bid * NWAVES + X.wid, NGW = X.G * NWAVES;
        const float* ng = X.in(IN_N1G);
        for (int r = gw; r < MV; r += NGW) {
            const int mb = mbof(r);
            const float* xr = r < MP ? X.in(IN_X_P) + (size_t)r * D : X.in(IN_X_S) + (size_t)(r - MP) * D;
            const float* sc = MOD + (size_t)mb * 6144 + 1024;
            bf16_t* xo = (bf16_t*)(X.ws + WS_XG1) + (size_t)r * D;
            float ss = 0.f;
#pragma unroll
            for (int j = 0; j < 4; ++j) {
                const int c = 4 * X.lane + 256 * j;
                const f32x4 v = *(const f32x4*)(xr + c), g = *(const f32x4*)(ng + c), s = *(const f32x4*)(sc + c);
                ss += (v.x * v.x + v.y * v.y) + (v.z * v.z + v.w * v.w);
                const f32x4 y = v * g * (s + 1.0f);
                u32x2 w; w.x = cvt_pk_bf16(y.x, y.y); w.y = cvt_pk_bf16(y.z, y.w);
                *(u32x2*)(xo + c) = w;
            }
            ss = wave_sum(ss);
            if (X.lane < 16) ((float*)(X.ws + WS_SSA))[(size_t)r * 16 + X.lane] = X.lane == 0 ? ss : 0.f;
        }
    }
}

__device__ __forceinline__ void attn_microtile(const Ctx& X, int id, const LAS float* btab) {
    const bf16_t* ACT = (const bf16_t*)(X.ws + WS_ACT); const bf16_t* VT = (const bf16_t*)(X.ws + WS_VT);
    float* OG = (float*)(X.ws + WS_OG); float* LSE = (float*)(X.ws + WS_LSE);
    const int lane = X.lane, qi = lane & 15, kq = lane >> 4;
    int t = id; const int sub = t & 511; t >>= 9; const int hg = t & 3; t >>= 2; const int g = t % 3, b = t / 3;
    const int sh = 2 * g, ncl = 13 - sh;
    const int nsb = 1 << (ncl - 4);
    const int r = sub / nsb, s16 = sub % nsb;
    const int hd = 4 * g + hg, ilen = 1 << ncl;
    const int i0 = 16 * s16;
    const int tq = ((i0 + qi) << sh) + r;
    const size_t qrow = (size_t)(b * SEQ + tq) * NINP;
    bf16x8 qf[2];
#pragma unroll
    for (int ks = 0; ks < 2; ++ks) qf[ks] = *(const bf16x8*)(ACT + qrow + CQ + hd * 64 + 32 * ks + 8 * kq);
    f32x4 sc[10];
#pragma unroll
    for (int kt = 0; kt < 10; ++kt) {
        int ik = i0 - 128 + 16 * kt + qi; ik = ik < 0 ? 0 : (ik > ilen - 1 ? ilen - 1 : ik);
        const size_t krow = (size_t)(b * SEQ + (ik << sh) + r) * NINP + CK + hd * 64 + 8 * kq;
        const bf16x8 k0 = *(const bf16x8*)(ACT + krow), k1 = *(const bf16x8*)(ACT + krow + 32);
        f32x4 a = (f32x4){0.f, 0.f, 0.f, 0.f};
        a = MFMA16(k0, qf[0], a); a = MFMA16(k1, qf[1], a);
        sc[kt] = a;
    }
    float mx = -INFINITY;
#pragma unroll
    for (int kt = 0; kt < 10; ++kt)
#pragma unroll
        for (int e = 0; e < 4; ++e) {
            const int kk = 16 * kt + 4 * kq + e, j = 128 + qi - kk, ik = i0 - 128 + kk;
            const bool ok = (j >= 0) && (j <= 128) && (ik >= 0);
            const float s = ok ? sc[kt][e] * 0.125f + btab[hd * 132 + (ok ? j : 0)] : -INFINITY;
            sc[kt][e] = s; mx = fmaxf(mx, s);
        }
    mx = fmaxf(mx, __shfl_xor(mx, 16)); mx = fmaxf(mx, __shfl_xor(mx, 32));
    float l = 0.f;
#pragma unroll
    for (int kt = 0; kt < 10; ++kt)
#pragma unroll
        for (int e = 0; e < 4; ++e) { const float p = __expf(sc[kt][e] - mx); sc[kt][e] = p; l += p; }
    l += __shfl_xor(l, 16); l += __shfl_xor(l, 32);
    f32x4 o[4];
#pragma unroll
    for (int dt = 0; dt < 4; ++dt) o[dt] = (f32x4){0.f, 0.f, 0.f, 0.f};
    const bf16_t* vbase = VT + ((size_t)((b * 12 + hd) * 64 + qi)) * SEQ + (size_t)r * ilen;
#pragma unroll
    for (int ks2 = 0; ks2 < 5; ++ks2) {
        u32x4 pw; pw.x = cvt_pk_bf16(sc[2 * ks2][0], sc[2 * ks2][1]); pw.y = cvt_pk_bf16(sc[2 * ks2][2], sc[2 * ks2][3]);
        pw.z = cvt_pk_bf16(sc[2 * ks2 + 1][0], sc[2 * ks2 + 1][1]); pw.w = cvt_pk_bf16(sc[2 * ks2 + 1][2], sc[2 * ks2 + 1][3]);
        const bf16x8 pf = __builtin_bit_cast(bf16x8, pw);
        const int ia = i0 - 128 + 32 * ks2 + 4 * kq, ib = ia + 16;
        const bool oka = ia >= 0 && ia < ilen, okb = ib >= 0 && ib < ilen;
#pragma unroll
        for (int dt = 0; dt < 4; ++dt) {
            const bf16_t* vp = vbase + (size_t)(16 * dt) * SEQ;
            u32x2 va = (u32x2){0u, 0u}, vb = (u32x2){0u, 0u};
            if (oka) va = *(const u32x2*)(vp + ia);
            if (okb) vb = *(const u32x2*)(vp + ib);
            u32x4 vw; vw.x = va.x; vw.y = va.y; vw.z = vb.x; vw.w = vb.y;
            o[dt] = MFMA16(__builtin_bit_cast(bf16x8, vw), pf, o[dt]);
        }
    }
    const float inv = 1.0f / l;
    const size_t orow = (size_t)(b * SEQ + tq);
    float* op = OG + ((size_t)g * M + orow) * 256 + hg * 64 + 4 * kq;
#pragma unroll
    for (int dt = 0; dt < 4; ++dt) *(f32x4*)(op + 16 * dt) = o[dt] * inv;
    if (kq == 0) LSE[((size_t)g * M + orow) * 4 + hg] = mx + __logf(l);
}

constexpr int XS_RS = 144, BS_RS = 272;
constexpr int L_XS = 0, L_BS = L_XS + 128 * XS_RS, L_CS = L_BS + 128 * BS_RS, L_HB = L_CS + 128 * BS_RS, L_FL = L_HB + 64 * BS_RS;
static_assert(L_FL + 3 * 512 + 64 <= 131072, "ssd lds");

__device__ __forceinline__ void ssd_passA_item(const Ctx& X, int layer, int item) {
    const int S = item & (NSC - 1), h = (item >> 3) & 31, b = item >> 8, gi = h >> 2;
    const bf16_t* ACT = (const bf16_t*)(X.ws + WS_ACT); const float* DT = (const float*)(X.ws + WS_DT);
    float* YL = (float*)(X.ws + WS_YL); float* ACUM = (float*)(X.ws + WS_ACUM); bf16_t* CB = (bf16_t*)(X.ws + WS_CB);
    LAS unsigned char* lds = X.lds;
    LAS float* acs = (LAS float*)(lds + L_FL); LAS float* dtv = acs + 128; LAS float* wv = acs + 256; LAS float* misc = acs + 384;
    const int tid = X.tid, lane = X.lane, w = X.wid, l16 = lane & 15, kq = lane >> 4;
    const float A_h = -__expf(X.in(IN_ALOG)[layer * NH + h]), D_h = X.in(IN_DSKIP)[layer * NH + h];
    const int cc = tid % 40, rs = tid / 40; const bool stager = tid < 480;
    int ch0;
    int kind;
    if (cc < 8) { kind = 0; ch0 = h * 64 + cc * 8; } else if (cc < 24) { kind = 1; ch0 = 2048 + gi * 128 + (cc - 8) * 8; } else { kind = 2; ch0 = 3072 + gi * 128 + (cc - 24) * 8; }
    float cw[4][8], cbias[8];
    if (stager) {
        const float* cwp = X.in(IN_CONVW) + (size_t)layer * 4 * 4096; const float* cbp = X.in(IN_CONVB) + (size_t)layer * 4096;
#pragma unroll
        for (int i = 0; i < 8; ++i) { cbias[i] = cbp[ch0 + i];
#pragma unroll
            for (int t = 0; t < 4; ++t) cw[t][i] = cwp[t * 4096 + ch0 + i]; }
    }
    f32x4 Hacc[4];
#pragma unroll
    for (int pt = 0; pt < 4; ++pt) Hacc[pt] = (f32x4){0.f, 0.f, 0.f, 0.f};
    float abase = 0.f;
    __syncthreads();
    for (int c = 0; c < 8; ++c) {
        const int T0 = S * 1024 + c * 128; const size_t R0 = (size_t)b * SEQ + T0;
#pragma unroll
        for (int pt = 0; pt < 4; ++pt)
#pragma unroll
            for (int e = 0; e < 4; ++e) *(LAS bf16_t*)(lds + L_HB + (16 * pt + 4 * kq + e) * BS_RS + (16 * w + l16) * 2) = (bf16_t)f2bf(Hacc[pt][e]);
        if (stager) {
            const int r0 = rs * 11, r1 = r0 + 11 < 128 ? r0 + 11 : 128;
            const bf16_t* src = ACT + CX + ch0;
            float hist[3][8];
#pragma unroll
            for (int t = 0; t < 3; ++t) {
                const int tt = T0 + r0 - 3 + t;
                u32x4 v = (u32x4){0u, 0u, 0u, 0u};
                if (tt >= 0) v = *(const u32x4*)(src + ((size_t)b * SEQ + tt) * NINP);
                hist[t][0] = blo(v.x); hist[t][1] = bhi(v.x); hist[t][2] = blo(v.y); hist[t][3] = bhi(v.y); hist[t][4] = blo(v.z); hist[t][5] = bhi(v.z); hist[t][6] = blo(v.w); hist[t][7] = bhi(v.w);
            }
            LAS unsigned char* dst = kind == 0 ? lds + L_XS + (cc * 8) * 2 : (kind == 1 ? lds + L_BS + ((cc - 8) * 8) * 2 : lds + L_CS + ((cc - 24) * 8) * 2);
            const int rstride = kind == 0 ? XS_RS : BS_RS;
            for (int rr = r0; rr < r1; ++rr) {
                const u32x4 v = *(const u32x4*)(src + (R0 + rr) * NINP);
                float cur[8]; cur[0] = blo(v.x); cur[1] = bhi(v.x); cur[2] = blo(v.y); cur[3] = bhi(v.y); cur[4] = blo(v.z); cur[5] = bhi(v.z); cur[6] = blo(v.w); cur[7] = bhi(v.w);
                float y[8];
#pragma unroll
                for (int i = 0; i < 8; ++i) { y[i] = siluf_(cbias[i] + hist[0][i] * cw[0][i] + hist[1][i] * cw[1][i] + hist[2][i] * cw[2][i] + cur[i] * cw[3][i]);
                    hist[0][i] = hist[1][i]; hist[1][i] = hist[2][i]; hist[2][i] = cur[i]; }
                u32x4 o; o.x = cvt_pk_bf16(y[0], y[1]); o.y = cvt_pk_bf16(y[2], y[3]); o.z = cvt_pk_bf16(y[4], y[5]); o.w = cvt_pk_bf16(y[6], y[7]);
                *(LAS u32x4*)(dst + rr * rstride) = o;
                if (kind == 2 && (h & 3) == 0) *(u32x4*)(CB + (R0 + rr) * 1024 + gi * 128 + (cc - 24) * 8) = o;
            }
        }
        if (w == 0) {
            const float d0 = DT[(R0 + 2 * lane) * 32 + h], d1 = DT[(R0 + 2 * lane + 1) * 32 + h];
            const float a0 = d0 * A_h, a1 = d1 * A_h;
            float s = a0 + a1;
#pragma unroll
            for (int o = 1; o < 64; o <<= 1) { const float t = __shfl_up(s, o); if (lane >= o) s += t; }
            const float c1 = s, c0 = s - a1;
            const float tot = __shfl(s, 63);
            acs[2 * lane] = c0; acs[2 * lane + 1] = c1; dtv[2 * lane] = d0; dtv[2 * lane + 1] = d1;
            wv[2 * lane] = d0 * __expf(tot - c0); wv[2 * lane + 1] = d1 * __expf(tot - c1);
            ACUM[(R0 + 2 * lane) * 32 + h] = abase + c0; ACUM[(R0 + 2 * lane + 1) * 32 + h] = abase + c1;
            if (lane == 0) misc[0] = __expf(tot);
            abase += tot;
        }
        __syncthreads();
        const int lrow = 16 * w + l16;
        bf16x8 cf[4];
#pragma unroll
        for (int ks = 0; ks < 4; ++ks) cf[ks] = *(const LAS bf16x8*)(lds + L_CS + lrow * BS_RS + (32 * ks + 8 * kq) * 2);
        const float acl = acs[lrow];
        bf16x8 mf[4];
#pragma unroll
        for (int ks2 = 0; ks2 < 4; ++ks2) {
            unsigned pk[4];
#pragma unroll
            for (int hh = 0; hh < 2; ++hh) {
                const int st = 2 * ks2 + hh;
                f32x4 gacc = (f32x4){0.f, 0.f, 0.f, 0.f};
#pragma unroll
                for (int ks = 0; ks < 4; ++ks) { const bf16x8 bfr = *(const LAS bf16x8*)(lds + L_BS + (16 * st + l16) * BS_RS + (32 * ks + 8 * kq) * 2); gacc = MFMA16(bfr, cf[ks], gacc); }
                const f32x4 as4 = *(const LAS f32x4*)(acs + 16 * st + 4 * kq), dt4 = *(const LAS f32x4*)(dtv + 16 * st + 4 * kq);
                float mv[4];
#pragma unroll
                for (int e = 0; e < 4; ++e) { const int s = 16 * st + 4 * kq + e; const float arg = (s <= lrow) ? acl - as4[e] : -INFINITY; mv[e] = gacc[e] * __expf(arg) * dt4[e]; }
                pk[2 * hh] = cvt_pk_bf16(mv[0], mv[1]); pk[2 * hh + 1] = cvt_pk_bf16(mv[2], mv[3]);
            }
            u32x4 pw; pw.x = pk[0]; pw.y = pk[1]; pw.z = pk[2]; pw.w = pk[3];
            mf[ks2] = __builtin_bit_cast(bf16x8, pw);
        }
        f32x4 yd[4], yo[4];
#pragma unroll
        for (int pt = 0; pt < 4; ++pt) { yd[pt] = (f32x4){0.f, 0.f, 0.f, 0.f}; yo[pt] = (f32x4){0.f, 0.f, 0.f, 0.f}; }
        const int tq_ = l16 >> 2, tp_ = lane & 3;
#pragma unroll
        for (int ks2 = 0; ks2 < 4; ++ks2)
#pragma unroll
            for (int pt = 0; pt < 4; ++pt) {
                const LAS unsigned char* xa = lds + L_XS + (32 * ks2 + 4 * kq + tq_) * XS_RS + (16 * pt + 4 * tp_) * 2;
                const s16x4 lo = tr16(xa), hi = tr16(xa + 16 * XS_RS);
                const bf16x8 xf = (bf16x8){lo[0], lo[1], lo[2], lo[3], hi[0], hi[1], hi[2], hi[3]};
                yd[pt] = MFMA16(xf, mf[ks2], yd[pt]);
            }
#pragma unroll
        for (int ks = 0; ks < 4; ++ks)
#pragma unroll
            for (int pt = 0; pt < 4; ++pt) { const bf16x8 hf = *(const LAS bf16x8*)(lds + L_HB + (16 * pt + l16) * BS_RS + (32 * ks + 8 * kq) * 2); yo[pt] = MFMA16(hf, cf[ks], yo[pt]); }
        {
            const float eal = __expf(acl);
            float* yp = YL + (R0 + lrow) * DIN + h * 64 + 4 * kq;
#pragma unroll
            for (int pt = 0; pt < 4; ++pt) {
                const u32x2 xw = *(const LAS u32x2*)(lds + L_XS + lrow * XS_RS + (16 * pt + 4 * kq) * 2);
                f32x4 xv; xv[0] = blo(xw.x); xv[1] = bhi(xw.x); xv[2] = blo(xw.y); xv[3] = bhi(xw.y);
                *(f32x4*)(yp + 16 * pt) = yd[pt] + yo[pt] * eal + xv * D_h;
            }
        }
        {
            const float dec = misc[0];
#pragma unroll
            for (int pt = 0; pt < 4; ++pt) Hacc[pt] = Hacc[pt] * dec;
#pragma unroll
            for (int ks = 0; ks < 4; ++ks) {
                const int lr0 = 32 * ks + 8 * kq;
                const LAS unsigned char* ba = lds + L_BS + (lr0 + tq_) * BS_RS + (16 * w + 4 * tp_) * 2;
                const s16x4 blo_ = tr16(ba), bhi_ = tr16(ba + 4 * BS_RS);
                const bf16x8 bfr = (bf16x8){blo_[0], blo_[1], blo_[2], blo_[3], bhi_[0], bhi_[1], bhi_[2], bhi_[3]};
                const f32x4 w0 = *(const LAS f32x4*)(wv + lr0), w1 = *(const LAS f32x4*)(wv + lr0 + 4);
#pragma unroll
                for (int pt = 0; pt < 4; ++pt) {
                    const LAS unsigned char* xa = lds + L_XS + (lr0 + tq_) * XS_RS + (16 * pt + 4 * tp_) * 2;
                    const s16x4 lo = tr16(xa), hi = tr16(xa + 4 * XS_RS);
                    u32x4 xw;
                    xw.x = cvt_pk_bf16(bf2f((unsigned short)lo[0]) * w0[0], bf2f((unsigned short)lo[1]) * w0[1]); xw.y = cvt_pk_bf16(bf2f((unsigned short)lo[2]) * w0[2], bf2f((unsigned short)lo[3]) * w0[3]);
                    xw.z = cvt_pk_bf16(bf2f((unsigned short)hi[0]) * w1[0], bf2f((unsigned short)hi[1]) * w1[1]); xw.w = cvt_pk_bf16(bf2f((unsigned short)hi[2]) * w1[2], bf2f((unsigned short)hi[3]) * w1[3]);
                    Hacc[pt] = MFMA16(__builtin_bit_cast(bf16x8, xw), bfr, Hacc[pt]);
                }
            }
        }
        __syncthreads();
    }
    {
        float* hl = (float*)(X.ws + WS_HLOC) + ((size_t)((b * NH + h) * NSC + S)) * 8192;
#pragma unroll
        for (int pt = 0; pt < 4; ++pt)
#pragma unroll
            for (int e = 0; e < 4; ++e) hl[(16 * pt + 4 * kq + e) * 128 + 16 * w + l16] = Hacc[pt][e];
        if (w == 0 && lane == 0) ((float*)(X.ws + WS_ATOT))[(b * NH + h) * NSC + S] = abase;
    }
}

__device__ __forceinline__ void sample_attn_item(const Ctx& X, int layer, int item, const LAS float* btab) {
    const int b = item >> 2, hg = item & 3;
    const bf16_t* ACT = (const bf16_t*)(X.ws + WS_ACT);
    LAS float* sm = (LAS float*)(X.lds + 8192);
    const int lane = X.lane, w = X.wid;
    const size_t arow = (size_t)(MP + b) * NINP;
    __syncthreads();
    if (w < 3) {
        const int g = w, sh = 2 * g, Lb = 128 << sh, hd = 4 * g + hg;
        LAS float* q = sm + g * 320; LAS float* p = q + 64; LAS float* og = p + 136; LAS float* lse = og + 64;
        const float* cache = kvcache(X, g) + ((size_t)(layer * NBS + b) * Lb) * 512;
        const float knew = bf2f(ACT[arow + CK + hd * 64 + lane]), vnew = bf2f(ACT[arow + CV + hd * 64 + lane]);
        q[lane] = bf2f(ACT[arow + CQ + hd * 64 + lane]);
        { float* orow = X.out + kvs_off(g) + ((size_t)(layer * NBS + b) * Lb + (Lb - 1)) * 512;
          orow[hg * 64 + lane] = knew; orow[256 + hg * 64 + lane] = vnew; }
        float s[3];
        const float s0 = wave_sum(q[lane] * knew);
#pragma unroll
        for (int rnd = 0; rnd < 3; ++rnd) {
            const int j = rnd * 64 + lane; float acc = 0.f;
            if (j >= 1 && j <= 128) {
                const float* kr = cache + (size_t)(Lb - (j << sh)) * 512 + hg * 64;
#pragma unroll
                for (int d4 = 0; d4 < 16; ++d4) { const f32x4 kv = *(const f32x4*)(kr + 4 * d4); const f32x4 qv = *(const LAS f32x4*)(q + 4 * d4); acc += (kv.x * qv.x + kv.y * qv.y) + (kv.z * qv.z + kv.w * qv.w); }
            }
            if (j == 0) acc = s0;
            s[rnd] = (j <= 128) ? acc * 0.125f + btab[hd * 132 + (j <= 128 ? j : 0)] : -INFINITY;
        }
        const float mx = wave_max(fmaxf(fmaxf(s[0], s[1]), s[2]));
        float l = 0.f;
#pragma unroll
        for (int rnd = 0; rnd < 3; ++rnd) { const int j = rnd * 64 + lane; const float pv = __expf(s[rnd] - mx); if (j <= 128) { p[j] = pv; l += pv; } }
        l = wave_sum(l);
        asm volatile("s_waitcnt lgkmcnt(0)" ::: "memory");
        float o = p[0] * vnew;
        const float* vb = cache + 256 + hg * 64 + lane;
#pragma unroll 8
        for (int j = 1; j <= 128; ++j) o += p[j] * vb[(size_t)(Lb - (j << sh)) * 512];
        og[lane] = o / l;
        if (lane == 0) lse[0] = mx + __logf(l);
    }
    __syncthreads();
    if (w == 0) {
        const float l0 = sm[0 * 320 + 264], l1 = sm[1 * 320 + 264], l2 = sm[2 * 320 + 264];
        const float mm = fmaxf(l0, fmaxf(l1, l2)); const float e0 = __expf(l0 - mm), e1 = __expf(l1 - mm), e2 = __expf(l2 - mm); const float inv = 1.0f / (e0 + e1 + e2);
        const float v = (e0 * sm[0 * 320 + 200 + lane] + e1 * sm[1 * 320 + 200 + lane] + e2 * sm[2 * 320 + 200 + lane]) * inv;
        ((bf16_t*)(X.ws + WS_ATTN))[(size_t)(MP + b) * 256 + hg * 64 + lane] = (bf16_t)f2bf(v);
    }
}

__device__ __forceinline__ void sample_ssd_item(const Ctx& X, int layer, int item) {
    const int b = item >> 3, gi = item & 7;
    const bf16_t* ACT = (const bf16_t*)(X.ws + WS_ACT); const float* DT = (const float*)(X.ws + WS_DT);
    LAS float* xs = (LAS float*)(X.lds + 16384); LAS float* Bs = xs + 256; LAS float* Cs = Bs + 128; LAS float* ys = Cs + 128; LAS float* red = ys + 256;
    const int tid = X.tid, lane = X.lane, w = X.wid;
    const size_t arow = (size_t)(MP + b) * NINP;
    __syncthreads();
    {
        const int ch = tid < 256 ? gi * 256 + tid : (tid < 384 ? 2048 + gi * 128 + (tid - 256) : 3072 + gi * 128 + (tid - 384));
        const float* st = X.in(IN_CONV) + ((size_t)(layer * NBS + b) * 3) * 4096 + ch;
        const float* cwp = X.in(IN_CONVW) + (size_t)layer * 4 * 4096 + ch;
        const float s0 = st[0], s1 = st[4096], s2 = st[8192], xr = bf2f(ACT[arow + CX + ch]);
        const float y = siluf_(X.in(IN_CONVB)[layer * 4096 + ch] + s0 * cwp[0] + s1 * cwp[4096] + s2 * cwp[8192] + xr * cwp[12288]);
        xs[tid] = y;
        float* co = X.out + O_CONVS + ((size_t)(layer * NBS + b) * 3) * 4096 + ch;
        co[0] = s1; co[4096] = s2; co[8192] = xr;
    }
    __syncthreads();
    {
        const int e = w >> 1, h = gi * 4 + e, half = lane >> 5, n4 = (lane & 31) * 4;
        const float dt = DT[(size_t)(MP + b) * 32 + h], A_h = -__expf(X.in(IN_ALOG)[layer * NH + h]), D_h = X.in(IN_DSKIP)[layer * NH + h];
        const float dA = __expf(dt * A_h);
        const f32x4 Bv = *(const LAS f32x4*)(Bs + n4), Cv = *(const LAS f32x4*)(Cs + n4);
        const float* hin = X.in(IN_SSM) + ((size_t)((layer * NBS + b) * NH + h)) * 8192;
        float* hout = X.out + O_SSMS + ((size_t)((layer * NBS + b) * NH + h)) * 8192;
#pragma unroll 4
        for (int it = 0; it < 16; ++it) {
            const int p = 32 * (w & 1) + 2 * it + half;
            const float xp = xs[e * 64 + p];
            const f32x4 hv = *(const f32x4*)(hin + p * 128 + n4);
            const f32x4 hn = hv * dA + Bv * (dt * xp);
            *(f32x4*)(hout + p * 128 + n4) = hn;
            float y = (hn.x * Cv.x + hn.y * Cv.y) + (hn.z * Cv.z + hn.w * Cv.w);
            y += __shfl_xor(y, 1); y += __shfl_xor(y, 2); y += __shfl_xor(y, 4); y += __shfl_xor(y, 8); y += __shfl_xor(y, 16);
            if ((lane & 31) == 0) ys[e * 64 + p] = y + D_h * xp;
        }
    }
    __syncthreads();
    if (tid < 256) {
        const float z = bf2f(ACT[arow + CZ + gi * 256 + tid]);
        const float gv = ys[tid] * siluf_(z);
        float ss = wave_sum(gv * gv);
        if (lane == 0) red[w] = ss;
        ys[tid] = gv;
    }
    __syncthreads();
    if (tid < 256) {
        const float tot = red[0] + red[1] + red[2] + red[3];
        const float rstd = rsqrtf(tot * (1.0f / 256.0f) + EPS);
        ((bf16_t*)(X.ws + WS_SSDN))[(size_t)(MP + b) * DIN + gi * 256 + tid] = (bf16_t)f2bf(ys[tid] * rstd * X.in(IN_SSDG)[layer * DIN + gi * 256 + tid]);
    }
}

__device__ __forceinline__ void phase_p2(const Ctx& X0, int layer) {
    const Ctx X = relaunder(X0);
    LAS float* btab = (LAS float*)X.lds;
    __syncthreads();
    for (int i = X.tid; i < 12 * 132; i += NTHREADS) btab[i] = ((const float*)(X.ws + WS_BTAB))[i];
    __syncthreads();
#ifndef P2MASK
#define P2MASK 15
#endif
    if (P2MASK & 1) for (int it = X.bid; it < NBS * 4; it += X.G) sample_attn_item(X, layer, it, btab);
    if (P2MASK & 2) for (int it = X.bid; it < NBS * 8; it += X.G) sample_ssd_item(X, layer, it);
    if (P2MASK & 4) for (int bw = X.bid; bw < 1536; bw += X.G) attn_microtile(X, bw * 8 + X.wid, btab);
    __syncthreads();
    if (P2MASK & 8) for (int it = X.bid; it < NBP * NH * NSC; it += X.G) ssd_passA_item(X, layer, it);
}

constexpr int HIN_RS = 272;
__device__ __forceinline__ void passB_item(const Ctx& X, int layer, int item) {
    const int gi = item & 7, c = (item >> 3) & 63, b = item >> 9, S = c >> 3;
    const bf16_t* ACT = (const bf16_t*)(X.ws + WS_ACT); const bf16_t* CB = (const bf16_t*)(X.ws + WS_CB);
    const float* YL = (const float*)(X.ws + WS_YL); const float* ACUM = (const float*)(X.ws + WS_ACUM); const float* ATOT = (const float*)(X.ws + WS_ATOT);
    const float* HLOC = (const float*)(X.ws + WS_HLOC);
    LAS unsigned char* lds = X.lds;
    const int tid = X.tid, lane = X.lane, w = X.wid, l16 = lane & 15, kq = lane >> 4;
    __syncthreads();
    if (S > 0) {
#pragma unroll
        for (int e = 0; e < 4; ++e) {
            const int h = gi * 4 + e; const float* at = ATOT + (b * NH + h) * NSC; const float* hl = HLOC + ((size_t)(b * NH + h) * NSC) * 8192;
            f32x4 a[4];
#pragma unroll
            for (int i = 0; i < 4; ++i) a[i] = (f32x4){0.f, 0.f, 0.f, 0.f};
            float lg = 0.f;
            for (int sp = S - 1; sp >= 0; --sp) {
                const float wgt = __expf(lg);
                if (wgt == 0.f) break;
#pragma unroll
                for (int i = 0; i < 4; ++i) a[i] += *(const f32x4*)(hl + (size_t)sp * 8192 + (i * 512 + tid) * 4) * wgt;
                lg += at[sp];
            }
#pragma unroll
            for (int i = 0; i < 4; ++i) { const int idx = (i * 512 + tid) * 4, p = idx >> 7, n = idx & 127;
                u32x2 o; o.x = cvt_pk_bf16(a[i][0], a[i][1]); o.y = cvt_pk_bf16(a[i][2], a[i][3]);
                *(LAS u32x2*)(lds + (e * 64 + p) * HIN_RS + n * 2) = o; }
        }
    }
    __syncthreads();
    const size_t row = (size_t)b * SEQ + c * 128 + 16 * w + l16;
    f32x4 acc[4][4];
#pragma unroll
    for (int e = 0; e < 4; ++e)
#pragma unroll
        for (int pt = 0; pt < 4; ++pt) acc[e][pt] = (f32x4){0.f, 0.f, 0.f, 0.f};
    if (S > 0) {
#pragma unroll
        for (int ks = 0; ks < 4; ++ks) {
            const bf16x8 cf = *(const bf16x8*)(CB + row * 1024 + gi * 128 + 32 * ks + 8 * kq);
#pragma unroll
            for (int e = 0; e < 4; ++e)
#pragma unroll
                for (int pt = 0; pt < 4; ++pt) { const bf16x8 hf = *(const LAS bf16x8*)(lds + (e * 64 + 16 * pt + l16) * HIN_RS + (32 * ks + 8 * kq) * 2); acc[e][pt] = MFMA16(hf, cf, acc[e][pt]); }
        }
    }
    float ss = 0.f;
#pragma unroll
    for (int e = 0; e < 4; ++e) {
        const int h = gi * 4 + e; const float ea = S > 0 ? __expf(ACUM[row * 32 + h]) : 0.f;
#pragma unroll
        for (int pt = 0; pt < 4; ++pt) {
            const int col = h * 64 + 16 * pt + 4 * kq;
            const f32x4 yl = *(const f32x4*)(YL + row * DIN + col);
            const u32x2 zw = *(const u32x2*)(ACT + row * NINP + CZ + col);
            f32x4 y = yl + acc[e][pt] * ea;
            y[0] *= siluf_(blo(zw.x)); y[1] *= siluf_(bhi(zw.x)); y[2] *= siluf_(blo(zw.y)); y[3] *= siluf_(bhi(zw.y));
            ss += (y[0] * y[0] + y[1] * y[1]) + (y[2] * y[2] + y[3] * y[3]);
            acc[e][pt] = y;
        }
    }
    ss += __shfl_xor(ss, 16); ss += __shfl_xor(ss, 32);
    const float rstd = rsqrtf(ss * (1.0f / 256.0f) + EPS);
    const float* ng = X.in(IN_SSDG) + (size_t)layer * DIN;
    bf16_t* so = (bf16_t*)(X.ws + WS_SSDN) + row * DIN;
#pragma unroll
    for (int e = 0; e < 4; ++e)
#pragma unroll
        for (int pt = 0; pt < 4; ++pt) {
            const int col = (gi * 4 + e) * 64 + 16 * pt + 4 * kq;
            const f32x4 g = *(const f32x4*)(ng + col); const f32x4 y = acc[e][pt] * rstd * g;
            u32x2 o; o.x = cvt_pk_bf16(y[0], y[1]); o.y = cvt_pk_bf16(y[2], y[3]);
            *(u32x2*)(so + col) = o;
        }
}

__device__ __forceinline__ void phase_p3(const Ctx& X0, int layer) {
    const Ctx X = relaunder(X0);
    for (int it = X.bid; it < NBP * 64 * 8; it += X.G) passB_item(X, layer, it);
    {
        const float* ATOT = (const float*)(X.ws + WS_ATOT); const float* HLOC = (const float*)(X.ws + WS_HLOC);
        for (int it = X.bid; it < NBP * NH; it += X.G) {
            const float* at = ATOT + it * NSC; const float* hl = HLOC + (size_t)it * NSC * 8192;
            f32x4 a[4];
#pragma unroll
            for (int i = 0; i < 4; ++i) a[i] = (f32x4){0.f, 0.f, 0.f, 0.f};
            float lg = 0.f;
            for (int sp = NSC - 1; sp >= 0; --sp) {
                const float wgt = __expf(lg);
                if (wgt == 0.f) break;
#pragma unroll
                for (int i = 0; i < 4; ++i) a[i] += *(const f32x4*)(hl + (size_t)sp * 8192 + (i * 512 + X.tid) * 4) * wgt;
                lg += at[sp];
            }
            float* o = X.out + O_SSMP + ((size_t)layer * NBP * NH + it) * 8192;
#pragma unroll
            for (int i = 0; i < 4; ++i) *(f32x4*)(o + (i * 512 + X.tid) * 4) = a[i];
        }
    }
    const int gw = X.bid * NWAVES + X.wid, NGW = X.G * NWAVES, lane = X.lane;
    {
        const float* OG = (const float*)(X.ws + WS_OG); const float* LSE = (const float*)(X.ws + WS_LSE); bf16_t* AT = (bf16_t*)(X.ws + WS_ATTN);
        for (int row = gw; row < MP; row += NGW) {
            const int hg = lane >> 4;
            const float l0 = LSE[((size_t)0 * M + row) * 4 + hg], l1 = LSE[((size_t)1 * M + row) * 4 + hg], l2 = LSE[((size_t)2 * M + row) * 4 + hg];
            const float mm = fmaxf(l0, fmaxf(l1, l2)); const float e0 = __expf(l0 - mm), e1 = __expf(l1 - mm), e2 = __expf(l2 - mm); const float inv = 1.0f / (e0 + e1 + e2);
            const f32x4 a = *(const f32x4*)(OG + ((size_t)0 * M + row) * 256 + 4 * lane), bq = *(const f32x4*)(OG + ((size_t)1 * M + row) * 256 + 4 * lane), cq = *(const f32x4*)(OG + ((size_t)2 * M + row) * 256 + 4 * lane);
            const f32x4 v = (a * e0 + bq * e1 + cq * e2) * inv;
            u32x2 o; o.x = cvt_pk_bf16(v[0], v[1]); o.y = cvt_pk_bf16(v[2], v[3]);
            *(u32x2*)(AT + (size_t)row * 256 + 4 * lane) = o;
        }
    }
    {
        const bf16_t* ACT = (const bf16_t*)(X.ws + WS_ACT);
        for (int it = gw; it < 10752; it += NGW) {
            int g, r = it; if (r < 512) g = 0; else if (r < 2560) { g = 1; r -= 512; } else { g = 2; r -= 2560; }
            const int win = 128 << (2 * g), kv = r & 1, i = (r >> 1) % win, b = (r >> 1) / win;
            const size_t arow = ((size_t)b * SEQ + (SEQ - win + i)) * NINP + (kv ? CV : CK) + g * 256 + 4 * lane;
            const u32x2 v = *(const u32x2*)(ACT + arow);
            f32x4 o; o[0] = blo(v.x); o[1] = bhi(v.x); o[2] = blo(v.y); o[3] = bhi(v.y);
            *(f32x4*)(X.out + kvp_off(g) + ((((size_t)layer * NBP + b) * win + i) * 2 + kv) * 256 + 4 * lane) = o;
        }
        for (int it = gw; it < NBP * 3 * 16; it += NGW) {
            const int pc = it & 15, i = (it >> 4) % 3, b = it / 48;
            const u32x2 v = *(const u32x2*)(ACT + ((size_t)b * SEQ + SEQ - 3 + i) * NINP + CX + pc * 256 + 4 * lane);
            f32x4 o; o[0] = blo(v.x); o[1] = bhi(v.x); o[2] = blo(v.y); o[3] = bhi(v.y);
            *(f32x4*)(X.out + O_CONVP + (((size_t)layer * NBP + b) * 3 + i) * 4096 + pc * 256 + 4 * lane) = o;
        }
    }
}

__device__ __forceinline__ void phase_final(const Ctx& X0) {
    const Ctx X = relaunder(X0);
    const int gw = X.bid * NWAVES + X.wid, NGW = X.G * NWAVES, lane = X.lane;
    const float* XA = (const float*)(X.ws + WS_XA); const float* SS = (const float*)(X.ws + WS_SSA); const float* fg = X.in(IN_FING);
    for (int r = gw; r < MV; r += NGW) {
        const float rstd = row_rstd(SS, r);
        float* o = r < MP ? X.out + O_YP + (size_t)r * D : X.out + O_YS + (size_t)(r - MP) * D;
#pragma unroll
        for (int j = 0; j < 4; ++j) { const int c = 4 * lane + 256 * j; *(f32x4*)(o + c) = *(const f32x4*)(XA + (size_t)r * D + c) * rstd * *(const f32x4*)(fg + c); }
    }
}


#define XB_TMO      128
#define XB_XCNT(j)  (256  + 64 * (j))
#define XB_XSUB(j)  (1280 + 64 * (j))
#define XB_XGEN(j)  (2304 + 64 * (j))
#define XB_TOP      3328
#define XB_TOPGEN   3392
#define XCD_BAR_WORDS 3456
#define XB_SPIN_CAP (1u << 18)
__device__ __forceinline__ unsigned xb_ld(unsigned* p)              { return __hip_atomic_load(p, __ATOMIC_RELAXED, __HIP_MEMORY_SCOPE_AGENT); }
__device__ __forceinline__ unsigned xb_add(unsigned* p, unsigned v) { return __hip_atomic_fetch_add(p, v, __ATOMIC_RELAXED, __HIP_MEMORY_SCOPE_AGENT); }
__device__ __forceinline__ unsigned xb_xcc_id() { return (unsigned)__builtin_amdgcn_s_getreg((3 << 11) | 20) & 0xFu; }
#define XB_SPIN(cond, bar) do { unsigned _sp = 0; while (cond) { __builtin_amdgcn_s_sleep(1); \
    if ((++_sp & 255u) == 0u) { if (xb_ld(&(bar)[XB_TMO])) break; if (_sp > XB_SPIN_CAP) { atomicAdd(&(bar)[XB_TMO], 1u); break; } } } } while (0)
struct XcdBarrier { unsigned* bar; unsigned x; volatile LAS unsigned* st; };
__device__ __forceinline__ XcdBarrier xcd_barrier_post(unsigned* bar, volatile LAS unsigned* st) {
    XcdBarrier b; b.bar = bar; b.x = xb_xcc_id(); b.st = st;
    if (threadIdx.x == 0) (void)xb_add(&bar[XB_XCNT(b.x)], 1u);
    return b;
}
__device__ __forceinline__ void xcd_barrier_complete(unsigned* bar, unsigned x, unsigned& nloc, unsigned& nx) {
    const unsigned G = gridDim.x * gridDim.y * gridDim.z;
    unsigned sum, cnt, mine, sp = 0u;
    for (;;) {
        sum = 0u; cnt = 0u; mine = 0u;
#pragma unroll
        for (unsigned j = 0; j < 16; ++j) { const unsigned c = xb_ld(&bar[XB_XCNT(j)]); sum += c; cnt += (c > 0u) ? 1u : 0u; mine = (j == x) ? c : mine; }
        if (sum == G) break;
        __builtin_amdgcn_s_sleep(1);
        if ((++sp & 255u) == 0u) { if (xb_ld(&bar[XB_TMO])) break; if (sp > XB_SPIN_CAP) { atomicAdd(&bar[XB_TMO], 1u); break; } }
    }
    nloc = mine > 0u ? mine : 1u; nx = cnt > 0u ? cnt : 1u;
}
__device__ __forceinline__ void xcd_barrier(const XcdBarrier& b) {
    asm volatile("s_waitcnt vmcnt(0)" ::: "memory");
    __syncthreads();
    if (threadIdx.x == 0) {
        unsigned* bar = b.bar;
        __builtin_amdgcn_s_waitcnt(0);
        unsigned nloc = b.st[0], nx = b.st[1];
        if (nloc == 0u) { xcd_barrier_complete(bar, b.x, nloc, nx); b.st[0] = nloc; b.st[1] = nx; }
        const unsigned old = xb_add(&bar[XB_XSUB(b.x)], 1u);
        const unsigned gen = old / nloc;
        if (old + 1u == (gen + 1u) * nloc) {
            __builtin_amdgcn_fence(__ATOMIC_RELEASE, "agent");
            asm volatile("s_waitcnt vmcnt(0)" ::: "memory");
            const unsigned og = xb_add(&bar[XB_TOP], 1u);
            const unsigned tg = og / nx;
            if (og + 1u == (tg + 1u) * nx) xb_add(&bar[XB_TOPGEN], 1u);
            else XB_SPIN(xb_ld(&bar[XB_TOPGEN]) == tg, bar);
            __builtin_amdgcn_fence(__ATOMIC_ACQUIRE, "agent");
            xb_add(&bar[XB_XGEN(b.x)], 1u);
            asm volatile("s_waitcnt vmcnt(0)" ::: "memory");
        } else {
            XB_SPIN(xb_ld(&bar[XB_XGEN(b.x)]) == gen, bar);
            __builtin_amdgcn_fence(__ATOMIC_ACQUIRE, "agent");
            asm volatile("s_waitcnt vmcnt(0)" ::: "memory");
        }
    }
    __syncthreads();
}
constexpr int LDS_BAR_OFF = 139264;

constexpr int N_PHASES = 2 + 7 * NLAYER + 1;

__global__ void __launch_bounds__(NTHREADS, 2) fwd_megakernel(Args args) {
    extern __shared__ __attribute__((aligned(16))) unsigned char lds_raw[];
    const int wid_ = __builtin_amdgcn_readfirstlane((int)threadIdx.x >> 6);
    const Ctx X{args, (LAS unsigned char*)lds_raw, 0, 0, wid_, (int)gridDim.x, (int)blockIdx.x, args.out, args.ws};
    const int lo = args.ph_lo, hi = args.ph_hi;
#if MK_ONE_LAUNCH
    cg::grid_group grid = cg::this_grid();
    if (threadIdx.x < 2) ((volatile LAS unsigned*)(X.lds + LDS_BAR_OFF))[threadIdx.x] = 0u;
    __syncthreads();
    const XcdBarrier xbar = xcd_barrier_post((unsigned*)(args.ws + WS_CTL), (volatile LAS unsigned*)(X.lds + LDS_BAR_OFF));
#define SEAM() xcd_barrier(xbar)
#else
#define SEAM() do {} while (0)
#endif
#ifndef PHMASK
#define PHMASK 0xFFFFFFFFu
#endif
#define PHON(j) ((PHMASK >> (j)) & 1u)
#ifndef REPMASK
#define REPMASK 0u
#endif
#define NREP(j) (1 + ((REPMASK >> (j)) & 1u))
#define IN(k) (lo <= (k) && (k) < hi)
#define SEAM_AFTER(k) do { if (IN(k) && IN((k) + 1)) SEAM(); } while (0)
    if (PHON(0) && IN(0)) { for (int rep = 0; rep < NREP(0); ++rep) { if (rep) SEAM(); phase_p0a(X); } }
#if MK_ONE_LAUNCH
    if (IN(0) && IN(1)) grid.sync();
#endif
    if (PHON(1) && IN(1)) { for (int rep = 0; rep < NREP(1); ++rep) { if (rep) SEAM(); phase_p0b(X); } } SEAM_AFTER(1);
    for (int l = 0; l < NLAYER; ++l) {
        const int pb = 2 + 7 * l;
        if (PHON(2) && IN(pb + 0)) {
            const Ctx Y = relaunder(X); unsigned char* ws = Y.ws; unsigned char* wl = ws + WS_W + (size_t)l * WL_SIZE; const float* MOD = (const float*)(ws + WS_MOD); (void)MOD;
            pg8::Gemm g{(const bf16_t*)(ws + WS_XG1), (const bf16_t*)(wl + WL_IN), M, NINP, D}; pg8::StaticOrder S; S.init(M, NINP, Y.G, Y.bid);
            EpiIn E{(bf16_t*)(ws + WS_ACT), (float*)(ws + WS_DT), (bf16_t*)(ws + WS_VT), (const float*)(ws + WS_SSA), (const float*)(ws + WS_BIAS1) + (size_t)l * NMB * NINP, args.in[IN_DTB] + l * NH};
            pg8::gemm_phase<EpiIn, pg8::StaticOrder, true, true>(Y.lds, g, S, E, Y.wid);
        }
        SEAM_AFTER(pb + 0);
        if (PHON(3) && IN(pb + 1)) { for (int rep = 0; rep < NREP(3); ++rep) { if (rep) SEAM(); phase_p2(X, l); } }
        SEAM_AFTER(pb + 1);
        if (PHON(4) && IN(pb + 2)) { for (int rep = 0; rep < NREP(4); ++rep) { if (rep) SEAM(); phase_p3(X, l); } }
        SEAM_AFTER(pb + 2);
        if (PHON(5) && IN(pb + 3)) {
            const Ctx Y = relaunder(X); unsigned char* ws = Y.ws; unsigned char* wl = ws + WS_W + (size_t)l * WL_SIZE; const float* MOD = (const float*)(ws + WS_MOD); (void)MOD; (void)wl;
#ifndef G4MASK
#define G4MASK 3
#endif
            if (G4MASK & 1) { pg8::Gemm g{(const bf16_t*)(ws + WS_ATTN), (const bf16_t*)(wl + WL_OA), M, D, 256}; pg8::StaticOrder S; S.init(M, D, Y.G, Y.bid);
              EpiT1 E{(const bf16_t*)(ws + WS_ACT), (float*)(ws + WS_T1)};
              pg8::gemm_phase<EpiT1, pg8::StaticOrder, true, true>(Y.lds, g, S, E, Y.wid); }
            if (G4MASK & 2) { pg8::Gemm g{(const bf16_t*)(ws + WS_SSDN), (const bf16_t*)(wl + WL_OS), M, D, DIN}; pg8::StaticOrder S; S.init(M, D, Y.G, Y.bid);
              EpiMerge E{(const bf16_t*)(ws + WS_ACT), (const float*)(ws + WS_T1), (bf16_t*)(ws + WS_MERGED)};
              pg8::gemm_phase<EpiMerge, pg8::StaticOrder, true, true>(Y.lds, g, S, E, Y.wid); }
        }
        SEAM_AFTER(pb + 3);
        if (PHON(6) && IN(pb + 4)) {
            const Ctx Y = relaunder(X); unsigned char* ws = Y.ws; unsigned char* wl = ws + WS_W + (size_t)l * WL_SIZE; const float* MOD = (const float*)(ws + WS_MOD); (void)MOD; (void)wl;
            pg8::Gemm g{(const bf16_t*)(ws + WS_MERGED), (const bf16_t*)(wl + WL_OUT), M, D, D}; pg8::StaticOrder S; S.init(M, D, Y.G, Y.bid);
            const float* xp = l == 0 ? args.in[IN_X_P] : (const float*)(ws + WS_XA); const float* xs = l == 0 ? args.in[IN_X_S] : (const float*)(ws + WS_XA) + (size_t)MP * D;
            EpiRes<true> E{xp, xs, MOD + (size_t)l * NMB * 6144 + 2048, (float*)(ws + WS_X1), (float*)(ws + WS_SSB), (bf16_t*)(ws + WS_XG2), args.in[IN_N2G] + (size_t)l * D, MOD + (size_t)l * NMB * 6144 + 4096};
            pg8::gemm_phase<EpiRes<true>, pg8::StaticOrder, true, true>(Y.lds, g, S, E, Y.wid);
        }
        SEAM_AFTER(pb + 4);
        if (PHON(7) && IN(pb + 5)) {
            const Ctx Y = relaunder(X); unsigned char* ws = Y.ws; unsigned char* wl = ws + WS_W + (size_t)l * WL_SIZE; const float* MOD = (const float*)(ws + WS_MOD); (void)MOD; (void)wl;
            pg8::Gemm g{(const bf16_t*)(ws + WS_XG2), (const bf16_t*)(wl + WL_UP), M, DFF, D}; pg8::StaticOrder S; S.init(M, DFF, Y.G, Y.bid);
            EpiUp E{(bf16_t*)(ws + WS_U), (const float*)(ws + WS_SSB), (const float*)(ws + WS_BIAS2) + (size_t)l * NMB * DFF};
            pg8::gemm_phase<EpiUp, pg8::StaticOrder, true, true>(Y.lds, g, S, E, Y.wid);
        }
        SEAM_AFTER(pb + 5);
        if (PHON(8) && IN(pb + 6)) {
            const Ctx Y = relaunder(X); unsigned char* ws = Y.ws; unsigned char* wl = ws + WS_W + (size_t)l * WL_SIZE; const float* MOD = (const float*)(ws + WS_MOD); (void)MOD; (void)wl;
            pg8::Gemm g{(const bf16_t*)(ws + WS_U), (const bf16_t*)(wl + WL_DN), M, D, DFF}; pg8::StaticOrder S; S.init(M, D, Y.G, Y.bid);
            const float* x1 = (const float*)(ws + WS_X1);
            if (l + 1 < NLAYER) {
                EpiRes<true> E{x1, x1 + (size_t)MP * D, MOD + (size_t)l * NMB * 6144 + 5120, (float*)(ws + WS_XA), (float*)(ws + WS_SSA), (bf16_t*)(ws + WS_XG1), args.in[IN_N1G] + (size_t)(l + 1) * D, MOD + (size_t)(l + 1) * NMB * 6144 + 1024};
                pg8::gemm_phase<EpiRes<true>, pg8::StaticOrder, true, true>(Y.lds, g, S, E, Y.wid);
            } else {
                EpiRes<false> E{x1, x1 + (size_t)MP * D, MOD + (size_t)l * NMB * 6144 + 5120, (float*)(ws + WS_XA), (float*)(ws + WS_SSA), nullptr, nullptr, nullptr};
                pg8::gemm_phase<EpiRes<false>, pg8::StaticOrder, true, true>(Y.lds, g, S, E, Y.wid);
            }
        }
        SEAM_AFTER(pb + 6);
    }
    if (PHON(9) && IN(N_PHASES - 1)) phase_final(X);
#undef IN
#undef SEAM_AFTER
#undef SEAM
}

extern "C" void kernel_launch(void* const* d_in, const int* in_sizes, int n_in, void* d_out, int out_size, void* d_ws, size_t ws_size, hipStream_t stream) {
    static int grid = 0;
    if (grid == 0) {
        if (n_in != 27 || (size_t)out_size != O_END || ws_size < WS_END) { fprintf(stderr, "kernel_launch: unexpected shapes: n_in %d out %d (want %zu) ws %zu (want %zu)\n", n_in, out_size, (size_t)O_END, ws_size, (size_t)WS_END); grid = -1; return; }
        int dev = 0, cus = 0, per_cu = 0;
        hipGetDevice(&dev); hipDeviceGetAttribute(&cus, hipDeviceAttributeMultiprocessorCount, dev);
        if (hipFuncSetAttribute((const void*)fwd_megakernel, hipFuncAttributeMaxDynamicSharedMemorySize, LDS_BYTES) != hipSuccess) { fprintf(stderr, "kernel_launch: hipFuncSetAttribute failed\n"); grid = -1; return; }
        if (hipOccupancyMaxActiveBlocksPerMultiprocessor(&per_cu, (const void*)fwd_megakernel, NTHREADS, LDS_BYTES) != hipSuccess || per_cu < 1) { fprintf(stderr, "kernel_launch: occupancy query says %d\n", per_cu); per_cu = 1; }
        (void)hipGetLastError();
        grid = cus;
    }
    if (grid < 0) return;
    if (hipMemsetAsync((char*)d_ws + WS_CTL, 0, 16384, stream) != hipSuccess) { fprintf(stderr, "kernel_launch: memset failed\n"); return; }
    Args a{};
    for (int i = 0; i < 27; ++i) a.in[i] = (const float*)d_in[i];
    a.out = (float*)d_out; a.ws = (unsigned char*)d_ws;
#if MK_ONE_LAUNCH
    a.ph_lo = 0; a.ph_hi = N_PHASES;
    void* kargs[] = {&a};
    hipError_t e = hipLaunchCooperativeKernel((const void*)fwd_megakernel, dim3(grid), dim3(NTHREADS), kargs, LDS_BYTES, stream);
    if (e != hipSuccess) fprintf(stderr, "cooperative launch failed: %s (grid %d)\n", hipGetErrorString(e), grid);
#else
    for (int p = 0; p < N_PHASES; ++p) { a.ph_lo = p; a.ph_hi = p + 1; hipLaunchKernelGGL(fwd_megakernel, dim3(grid), dim3(NTHREADS), LDS_BYTES, stream, a); }
#endif
}
```

```cpp
#include <hip/hip_runtime.h>
#include <hip/hip_cooperative_groups.h>
#include <cstdio>
#include <cstdint>
namespace cg = cooperative_groups;

#ifndef P2REP
#define P2REP 0
#endif
#ifndef MK_ONE_LAUNCH
#define MK_ONE_LAUNCH 1
#endif

#define LAS __attribute__((address_space(3)))
typedef unsigned short bf16_t;
typedef short bf16x8 __attribute__((ext_vector_type(8)));
typedef short s16x4 __attribute__((ext_vector_type(4)));
typedef float f32x4 __attribute__((ext_vector_type(4)));
typedef float f32x2 __attribute__((ext_vector_type(2)));
typedef unsigned u32x4 __attribute__((ext_vector_type(4)));
typedef unsigned u32x2 __attribute__((ext_vector_type(2)));

constexpr int D = 1024, SEQ = 8192, NBP = 2, NBS = 32, MP = NBP * SEQ, MV = MP + NBS, M = MP + 256, NMB = NBP + NBS;
constexpr int NIN = 10528, NINP = 10752, DFF = 4096, DIN = 2048, NH = 32, NLAYER = 2;
constexpr int CQ = 0, CK = 768, CV = 1536, CZ = 2304, CX = 4352, CG = 8448, CDT = 10496;
constexpr float EPS = 1e-6f;
constexpr int NSC = 8;

constexpr size_t AL(size_t x) { return (x + 255) & ~(size_t)255; }
constexpr size_t WS_CTL = 0;
constexpr size_t WS_MOD = (size_t)1 << 20;
constexpr size_t WS_BIAS1 = WS_MOD + AL((size_t)NLAYER * NMB * 6144 * 4);
constexpr size_t WS_BIAS2 = WS_BIAS1 + AL((size_t)NLAYER * NMB * NINP * 4);
constexpr size_t WS_BTAB = WS_BIAS2 + AL((size_t)NLAYER * NMB * DFF * 4);
constexpr size_t WS_SSA = WS_BTAB + AL(12 * 132 * 4);
constexpr size_t WS_SSB = WS_SSA + AL((size_t)M * 16 * 4);
constexpr size_t WS_SSSA = WS_SSB + AL((size_t)M * 16 * 4);
constexpr size_t WS_SSSB = WS_SSSA + AL(NBS * 64 * 4);
constexpr size_t WS_DT = WS_SSSB + AL(NBS * 64 * 4);
constexpr size_t WS_ACUM = WS_DT + AL((size_t)M * 32 * 4);
constexpr size_t WS_ATOT = WS_ACUM + AL((size_t)M * 32 * 4);
constexpr size_t WS_LSE = WS_ATOT + AL(NBP * NH * NSC * 4);
constexpr size_t WS_HLOC = WS_LSE + AL((size_t)3 * M * 4 * 4);
constexpr size_t WS_W = WS_HLOC + AL((size_t)NBP * NH * NSC * 8192 * 4);
constexpr size_t WL_IN = 0, WL_OA = WL_IN + (size_t)NINP * D * 2, WL_OS = WL_OA + (size_t)D * 256 * 2, WL_OUT = WL_OS + (size_t)D * DIN * 2,
                 WL_UP = WL_OUT + (size_t)D * D * 2, WL_DN = WL_UP + (size_t)DFF * D * 2, WL_SIZE = WL_DN + (size_t)D * DFF * 2;
constexpr size_t WS_XG1 = WS_W + NLAYER * WL_SIZE;
constexpr size_t WS_XG2 = WS_XG1 + (size_t)M * D * 2;
constexpr size_t WS_X1 = WS_XG2 + (size_t)M * D * 2;
constexpr size_t WS_XA = WS_X1 + (size_t)M * D * 4;
constexpr size_t WS_ATTN = WS_XA + (size_t)M * D * 4;
constexpr size_t WS_SSDN = WS_ATTN + (size_t)M * 256 * 2;
constexpr size_t WS_VT = WS_SSDN + (size_t)M * DIN * 2;
constexpr size_t WS_OG = WS_VT + (size_t)NBP * 12 * 64 * SEQ * 2;
constexpr size_t WS_YL = WS_OG + (size_t)3 * M * 256 * 4;
constexpr size_t WS_XBCP = WS_YL + (size_t)M * DIN * 2;
constexpr size_t WS_T1 = WS_XBCP, WS_MERGED = WS_XBCP + (size_t)M * D * 4;
constexpr size_t WS_ACT = WS_XBCP + (size_t)MP * 4096 * 2;
constexpr size_t WS_U = WS_ACT;
constexpr size_t WS_END = WS_ACT + (size_t)M * NINP * 2;
static_assert(WS_MERGED + (size_t)M * D * 2 <= WS_ACT, "overlay");
static_assert(WS_END <= ((size_t)1 << 30), "workspace map must fit 1 GiB");

constexpr size_t O_YP = 0;
constexpr size_t O_YS = O_YP + (size_t)MP * D;
constexpr size_t O_KVP0 = O_YS + (size_t)NBS * D;
constexpr size_t O_KVP1 = O_KVP0 + (size_t)2 * 2 * 128 * 512;
constexpr size_t O_KVP2 = O_KVP1 + (size_t)2 * 2 * 512 * 512;
constexpr size_t O_SSMP = O_KVP2 + (size_t)2 * 2 * 2048 * 512;
constexpr size_t O_CONVP = O_SSMP + (size_t)2 * 2 * 32 * 8192;
constexpr size_t O_KVS0 = O_CONVP + (size_t)2 * 2 * 3 * 4096;
constexpr size_t O_KVS1 = O_KVS0 + (size_t)2 * 32 * 128 * 512;
constexpr size_t O_KVS2 = O_KVS1 + (size_t)2 * 32 * 512 * 512;
constexpr size_t O_SSMS = O_KVS2 + (size_t)2 * 32 * 2048 * 512;
constexpr size_t O_CONVS = O_SSMS + (size_t)2 * 32 * 32 * 8192;
constexpr size_t O_END = O_CONVS + (size_t)2 * 32 * 3 * 4096;

__device__ __forceinline__ float bf2f(unsigned h) { return __uint_as_float(h << 16); }
__device__ __forceinline__ unsigned f2bf(float f) { unsigned u = __float_as_uint(f); return (u + 0x7fffu + ((u >> 16) & 1u)) >> 16; }
__device__ __forceinline__ unsigned cvt_pk_bf16(float lo, float hi) { unsigned r; asm volatile("v_cvt_pk_bf16_f32 %0, %1, %2" : "=v"(r) : "v"(lo), "v"(hi)); return r; }
__device__ __forceinline__ float blo(unsigned w) { return __uint_as_float(w << 16); }
__device__ __forceinline__ float bhi(unsigned w) { return __uint_as_float(w & 0xffff0000u); }
__device__ __forceinline__ float sigmoidf_(float x) { return 1.0f / (1.0f + __expf(-x)); }
__device__ __forceinline__ float siluf_(float x) { return x / (1.0f + __expf(-x)); }
__device__ __forceinline__ float softplusf_(float x) { return fmaxf(x, 0.f) + log1pf(__expf(-fabsf(x))); }
__device__ __forceinline__ int mbof(int r) { return r < MP ? (r >> 13) : (r - MP + NBP < NMB ? r - MP + NBP : NMB - 1); }
__device__ __forceinline__ float wave_sum(float v) {
#pragma unroll
    for (int o = 1; o < 64; o <<= 1) v += __shfl_xor(v, o);
    return v;
}
__device__ __forceinline__ float wave_max(float v) {
#pragma unroll
    for (int o = 1; o < 64; o <<= 1) v = fmaxf(v, __shfl_xor(v, o));
    return v;
}
typedef short v4i16_t __attribute__((ext_vector_type(4)));
__device__ __forceinline__ s16x4 tr16(const LAS unsigned char* p) { return __builtin_bit_cast(s16x4, __builtin_amdgcn_ds_read_tr16_b64_v4i16((LAS v4i16_t*)p)); }
#define MFMA16(a, b, c) __builtin_amdgcn_mfma_f32_16x16x32_bf16((a), (b), (c), 0, 0, 0)

namespace pg8 {
constexpr int BM = 256, BK = 64, HALF = 128, HTB = HALF * BK * 2, STAGE_BYTES = 8 * HTB, NXCD = 8, WGM = 8;
__host__ __device__ __forceinline__ int lds_byte(int r, int c) { const int st = (r >> 4) * 2 + (c >> 5), rr = r & 15, cc = c & 31, ob = rr * 64 + cc * 2; return st * 1024 + (ob ^ (((ob >> 9) & 1) << 5)); }
__host__ __device__ __forceinline__ void stage_rc(int b, int& R, int& C) { const int st = b / 1024, sb = b % 1024, swz = sb ^ (((sb >> 9) & 1) << 5); R = (st >> 1) * 16 + swz / 64; C = (st & 1) * 32 + (swz % 64) / 2; }
__host__ __device__ __forceinline__ int perm32(int rho) { const int n = rho >> 4, i = rho & 15; return 8 * (i >> 2) + 4 * n + (i & 3); }
struct Unit { int pm, pn; };
struct Gemm { const bf16_t* A; const bf16_t* Bt; int M, N, K; };
struct StaticOrder {
    int nM, nN, nwg, G, c;
    __host__ __device__ void init(int M_, int N_, int G_, int c_) { nM = M_ / BM; nN = N_ / BM; nwg = nM * nN; G = G_; c = c_; }
    __host__ __device__ bool next(int i, Unit& u) const {
        const long L = (long)i * G + c; if (L >= nwg) return false;
        int wgid = (int)L; { const int q = nwg / NXCD, r = nwg % NXCD, xcd = wgid % NXCD, off = wgid / NXCD; wgid = (xcd < r ? xcd * (q + 1) : r * (q + 1) + (xcd - r) * q) + off; }
        const int nig = WGM * nN, gid = wgid / nig, fm = gid * WGM, gsz = (nM - fm) < WGM ? (nM - fm) : WGM;
        u.pm = fm + ((wgid % nig) % gsz); u.pn = (wgid % nig) / gsz; return true;
    }
    __device__ __forceinline__ void a_ready(const Unit&) const {}
    __device__ __forceinline__ void done(const Unit&) const {}
};

template <class Epi, class Sched, bool ALIGN_EPI = false, bool SP2 = false>
__device__ __forceinline__ void gemm_phase(LAS unsigned char* lds, const Gemm g, const Sched& S, const Epi& E, int wid_in) {
    int wid = wid_in; asm volatile("" : "+s"(wid));
    int lane; asm volatile("v_mbcnt_lo_u32_b32 %0, -1, 0\n\tv_mbcnt_hi_u32_b32 %0, -1, %0" : "=v"(lane));
    const int tid = wid * 64 + lane, wr = wid >> 2, wc = wid & 3, fr = lane & 15, fq = lane >> 4;
    const int K = g.K, nt = K / BK;
    unsigned voffA[2], voffB[2];
#pragma unroll
    for (int i = 0; i < 2; ++i) { int R, C; stage_rc(tid * 16 + i * 8192, R, C); const int Rb = Epi::PERM ? ((R & ~31) + perm32(R & 31)) : R;
        voffA[i] = (unsigned)(R * K + C) * 2u; voffB[i] = (unsigned)(Rb * K + C) * 2u; }
    const size_t kstep = (size_t)(BK * 2);
    const size_t hstep = (size_t)HALF * K * 2;
    const size_t tstep = 2 * hstep;
    const unsigned ldsw = (unsigned)wid * 1024u;
    const int aoff = lds_byte(wr * 64 + fr, fq * 8), boff = lds_byte(wc * 32 + fr, fq * 8);
#define PG8_SA(b, h) (((b) * 2 + (h)) * HTB)
#define PG8_SB(b, h) ((4 + (b) * 2 + (h)) * HTB)
#define PG8_STAGE(bufoff, gbase, voff) do { _Pragma("unroll") for (int _i = 0; _i < 2; ++_i) \
        __builtin_amdgcn_global_load_lds((const unsigned*)((const char*)(gbase) + (voff)[_i]), (LAS unsigned*)(lds + (bufoff) + ldsw + _i * 8192), 16, 0, 0); } while (0)
#define PG8_LDA(dst, b, h) do { _Pragma("unroll") for (int m = 0; m < 4; ++m) _Pragma("unroll") for (int k = 0; k < 2; ++k) dst[m][k] = *(const LAS bf16x8*)(lds + PG8_SA(b, h) + aoff + m * 2048 + k * 1024); } while (0)
#define PG8_LDB(dst, b, h) do { _Pragma("unroll") for (int n = 0; n < 2; ++n) _Pragma("unroll") for (int k = 0; k < 2; ++k) dst[n][k] = *(const LAS bf16x8*)(lds + PG8_SB(b, h) + boff + n * 2048 + k * 1024); } while (0)
#define PG8_MMA(ai, bj, At, Bt) do { __builtin_amdgcn_s_setprio(1); _Pragma("unroll") for (int m = 0; m < 4; ++m) _Pragma("unroll") for (int n = 0; n < 2; ++n) _Pragma("unroll") for (int k = 0; k < 2; ++k) \
        acc[ai][bj][m][n] = __builtin_amdgcn_mfma_f32_16x16x32_bf16(Bt[n][k], At[m][k], acc[ai][bj][m][n], 0, 0, 0); __builtin_amdgcn_s_setprio(0); } while (0)
#define PG8_WAIT_V(n) asm volatile("s_waitcnt vmcnt(" #n ")" ::: "memory")
#define PG8_WAIT_L(n) asm volatile("s_waitcnt lgkmcnt(" #n ")" ::: "memory")
#define PG8_BAR __builtin_amdgcn_s_barrier()
#define PG8_SCHED __builtin_amdgcn_sched_barrier(0)
    Unit cur, nxt; int ui = 0;
    if (!S.next(0, cur)) return;
    f32x4 acc[2][2][4][2];
#pragma unroll
    for (int a = 0; a < 2; ++a)
#pragma unroll
        for (int b = 0; b < 2; ++b)
#pragma unroll
            for (int m = 0; m < 4; ++m)
#pragma unroll
                for (int n = 0; n < 2; ++n) acc[a][b][m][n] = (f32x4){0.f, 0.f, 0.f, 0.f};
    bf16x8 At[4][2], B0[2][2], B1[2][2];
    const char* cA = (const char*)g.A + (size_t)cur.pm * tstep; const char* cB = (const char*)g.Bt + (size_t)cur.pn * tstep;
    S.a_ready(cur);
    if constexpr (SP2) {
        PG8_STAGE(PG8_SB(0, 0), cB, voffB); PG8_STAGE(PG8_SB(0, 1), cB + hstep, voffB); PG8_STAGE(PG8_SA(0, 0), cA, voffA); PG8_STAGE(PG8_SA(0, 1), cA + hstep, voffA);
        if (wr == 1) PG8_BAR;
        PG8_WAIT_V(2); PG8_BAR;
        PG8_STAGE(PG8_SB(1, 0), cB + kstep, voffB); PG8_STAGE(PG8_SA(1, 0), cA + kstep, voffA); PG8_STAGE(PG8_SB(1, 1), cB + hstep + kstep, voffB);
        PG8_WAIT_V(6); PG8_BAR;
    } else {
        PG8_STAGE(PG8_SB(0, 0), cB, voffB); PG8_STAGE(PG8_SA(0, 0), cA, voffA); PG8_STAGE(PG8_SB(0, 1), cB + hstep, voffB); PG8_STAGE(PG8_SA(0, 1), cA + hstep, voffA);
        if (wr == 1) PG8_BAR;
        PG8_WAIT_V(4); PG8_BAR;
        PG8_STAGE(PG8_SB(1, 0), cB + kstep, voffB); PG8_STAGE(PG8_SA(1, 0), cA + kstep, voffA); PG8_STAGE(PG8_SB(1, 1), cB + hstep + kstep, voffB);
        PG8_WAIT_V(6); PG8_BAR;
    }
    for (;;) {
        const bool has_next = S.next(ui + 1, nxt);
        const char* nA = has_next ? (const char*)g.A + (size_t)nxt.pm * tstep : cA; const char* nB = has_next ? (const char*)g.Bt + (size_t)nxt.pn * tstep : cB;
#pragma unroll 1
        for (int t = 0; t < nt; t += 2) {
            const bool last = (t == nt - 2);
            const char* a1 = cA + (size_t)(t + 1) * kstep;
            const char* a2 = last ? nA : cA + (size_t)(t + 2) * kstep; const char* b2 = last ? nB : cB + (size_t)(t + 2) * kstep;
            const char* a3 = a2 + kstep; const char* b3 = b2 + kstep;
            if (last && has_next) S.a_ready(nxt);
            if constexpr (SP2) {
            PG8_LDB(B0, 0, 0); PG8_LDB(B1, 0, 1); PG8_SCHED; PG8_LDA(At, 0, 0); PG8_STAGE(PG8_SA(1, 1), a1 + hstep, voffA);
            PG8_WAIT_V(8); PG8_WAIT_L(0); PG8_BAR; PG8_MMA(0, 0, At, B0); PG8_MMA(0, 1, At, B1); PG8_BAR; PG8_SCHED;
            PG8_LDA(At, 0, 1); PG8_STAGE(PG8_SB(0, 0), b2, voffB); PG8_STAGE(PG8_SB(0, 1), b2 + hstep, voffB); PG8_STAGE(PG8_SA(0, 0), a2, voffA);
            PG8_WAIT_V(8); PG8_WAIT_L(0); PG8_BAR; PG8_MMA(1, 0, At, B0); PG8_MMA(1, 1, At, B1); PG8_BAR; PG8_SCHED;
            PG8_LDB(B0, 1, 0); PG8_LDB(B1, 1, 1); PG8_SCHED; PG8_LDA(At, 1, 0); PG8_STAGE(PG8_SA(0, 1), a2 + hstep, voffA);
            PG8_WAIT_V(8); PG8_WAIT_L(0); PG8_BAR; PG8_MMA(0, 0, At, B0); PG8_MMA(0, 1, At, B1); PG8_BAR; PG8_SCHED;
            PG8_LDA(At, 1, 1); PG8_STAGE(PG8_SB(1, 0), b3, voffB); PG8_STAGE(PG8_SB(1, 1), b3 + hstep, voffB); PG8_STAGE(PG8_SA(1, 0), a3, voffA);
            PG8_WAIT_V(8); PG8_WAIT_L(0); PG8_BAR; PG8_MMA(1, 0, At, B0); PG8_MMA(1, 1, At, B1); PG8_BAR; PG8_SCHED;
            } else {
            PG8_LDB(B0, 0, 0); PG8_SCHED; PG8_LDA(At, 0, 0); PG8_STAGE(PG8_SA(1, 1), a1 + hstep, voffA);
            PG8_WAIT_L(8); PG8_BAR; PG8_WAIT_L(0); PG8_MMA(0, 0, At, B0); PG8_BAR; PG8_SCHED;
            PG8_LDB(B1, 0, 1); PG8_STAGE(PG8_SB(0, 0), b2, voffB);
            PG8_BAR; PG8_WAIT_L(0); PG8_MMA(0, 1, At, B1); PG8_BAR;
            PG8_LDA(At, 0, 1); PG8_STAGE(PG8_SA(0, 0), a2, voffA);
            PG8_BAR; PG8_WAIT_L(0); PG8_MMA(1, 0, At, B0); PG8_BAR; PG8_SCHED;
            PG8_STAGE(PG8_SB(0, 1), b2 + hstep, voffB);
            PG8_WAIT_V(6); PG8_BAR; PG8_MMA(1, 1, At, B1); PG8_BAR;
            PG8_LDB(B0, 1, 0); PG8_SCHED; PG8_LDA(At, 1, 0); PG8_STAGE(PG8_SA(0, 1), a2 + hstep, voffA);
            PG8_WAIT_L(8); PG8_BAR; PG8_WAIT_L(0); PG8_MMA(0, 0, At, B0); PG8_BAR; PG8_SCHED;
            PG8_LDB(B1, 1, 1); PG8_STAGE(PG8_SB(1, 0), b3, voffB);
            PG8_BAR; PG8_WAIT_L(0); PG8_MMA(0, 1, At, B1); PG8_BAR;
            PG8_LDA(At, 1, 1); PG8_STAGE(PG8_SA(1, 0), a3, voffA);
            PG8_BAR; PG8_WAIT_L(0); PG8_MMA(1, 0, At, B0); PG8_BAR; PG8_SCHED;
            PG8_STAGE(PG8_SB(1, 1), b3 + hstep, voffB);
            PG8_WAIT_V(6); PG8_BAR; PG8_MMA(1, 1, At, B1); PG8_BAR;
            }
        }
        if constexpr (ALIGN_EPI) { if (wr == 0) PG8_BAR; }
        if constexpr (!Epi::AFTER_DRAIN) { int l2; asm volatile("v_mbcnt_lo_u32_b32 %0, -1, 0\n\tv_mbcnt_hi_u32_b32 %0, -1, %0" : "=v"(l2)); E(acc, cur, wr, wc, l2 & 15, l2 >> 4); S.done(cur); }
        if (!has_next) break;
#pragma unroll
        for (int a = 0; a < 2; ++a)
#pragma unroll
            for (int b = 0; b < 2; ++b)
#pragma unroll
                for (int m = 0; m < 4; ++m)
#pragma unroll
                    for (int n = 0; n < 2; ++n) acc[a][b][m][n] = (f32x4){0.f, 0.f, 0.f, 0.f};
        cur = nxt; cA = nA; cB = nB; ++ui;
        if constexpr (ALIGN_EPI) { if (wr == 1) PG8_BAR; }
    }
    PG8_WAIT_V(0);
    if constexpr (!ALIGN_EPI) { if (wr == 0) PG8_BAR; }
    PG8_BAR;
#undef PG8_SA
#undef PG8_SB
#undef PG8_STAGE
#undef PG8_LDA
#undef PG8_LDB
#undef PG8_MMA
#undef PG8_WAIT_V
#undef PG8_WAIT_L
#undef PG8_BAR
#undef PG8_SCHED
}
}

typedef f32x4 Acc[2][2][4][2];
constexpr int LDS_XCH = 131072;
#define EPI_ROWS_BEGIN \
    _Pragma("unroll") for (int ai = 0; ai < 2; ++ai) _Pragma("unroll") for (int m = 0; m < 4; ++m) { \
        const int r = u.pm * 256 + ai * 128 + wr * 64 + m * 16 + fr; if (r >= MV) continue;
#define EPI_ROWS_END }

__device__ __forceinline__ float row_rstd(const float* SS, int r) {
    const f32x4 a = *(const f32x4*)(SS + (size_t)r * 4);
    return rsqrtf(((a.x + a.y) + (a.z + a.w)) * (1.0f / D) + EPS);
}
__device__ __forceinline__ float row_ss_slot(const float* SS, int r, int fq) { return SS[(size_t)r * 4 + fq]; }
__device__ __forceinline__ float rstd_from_slot(float v) { v += __shfl_xor(v, 16); v += __shfl_xor(v, 32); return rsqrtf(v * (1.0f / D) + EPS); }
__device__ __forceinline__ float samp_rstd(const float* SSS, int t) {
    const f32x4* p = (const f32x4*)(SSS + (size_t)t * 64); float s = 0.f;
#pragma unroll
    for (int i = 0; i < 16; ++i) { const f32x4 a = p[i]; s += (a.x + a.y) + (a.z + a.w); }
    return rsqrtf(s * (1.0f / D) + EPS);
}
__device__ __forceinline__ u32x4 pack8(const f32x4 v0, const f32x4 v1) { u32x4 w; w.x = cvt_pk_bf16(v0[0], v0[1]); w.y = cvt_pk_bf16(v0[2], v0[3]); w.z = cvt_pk_bf16(v1[0], v1[1]); w.w = cvt_pk_bf16(v1[2], v1[3]); return w; }

struct EpiIn {
    static constexpr bool PERM = true, AFTER_DRAIN = false;
    bf16_t* ACT; float* DT; bf16_t* VT; const float* SS; const float* SSS; const float* BIAS; const float* dt_bias;
    __device__ __forceinline__ void tile_store(const f32x4 v0, const f32x4 v1, const pg8::Unit& u, int r, int colt, int c) const {
        if (u.pn < 41) {
            const u32x4 w = pack8(v0, v1);
            *(u32x4*)(ACT + (size_t)r * NINP + c) = w;
            if (u.pn >= 6 && u.pn <= 8 && r < MP) {
                const int g = u.pn - 6, sh = 2 * g  , b = r >> 13, t = r & (SEQ - 1);
                const int pos = ((t & ((1 << sh) - 1)) << (13 - sh)) + (t >> sh);
                const int hd = 4 * g + (colt >> 6), dd0 = colt & 63;
                bf16_t* vt = VT + ((size_t)((b * 12 + hd) * 64 + dd0)) * SEQ + pos;
                vt[0 * SEQ] = (bf16_t)(w.x & 0xffff); vt[1 * SEQ] = (bf16_t)(w.x >> 16); vt[2 * SEQ] = (bf16_t)(w.y & 0xffff); vt[3 * SEQ] = (bf16_t)(w.y >> 16);
                vt[4 * SEQ] = (bf16_t)(w.z & 0xffff); vt[5 * SEQ] = (bf16_t)(w.z >> 16); vt[6 * SEQ] = (bf16_t)(w.w & 0xffff); vt[7 * SEQ] = (bf16_t)(w.w >> 16);
            }
        } else if (colt < 32) {
            f32x4 o0, o1;
#pragma unroll
            for (int i = 0; i < 4; ++i) { o0[i] = softplusf_(v0[i] + dt_bias[colt + i]); o1[i] = softplusf_(v1[i] + dt_bias[colt + 4 + i]); }
            *(f32x4*)(DT + (size_t)r * 32 + colt) = o0; *(f32x4*)(DT + (size_t)r * 32 + colt + 4) = o1;
        }
    }
    __device__ __forceinline__ void operator()(const Acc& acc, const pg8::Unit& u, int wr, int wc, int fr, int fq) const {
        if (u.pm < 64) {
            const int mb = u.pm >> 5, r00 = u.pm * 256 + wr * 64 + fr;
            f32x4 bv[2][2]; float rs[2][4];
#pragma unroll
            for (int ai = 0; ai < 2; ++ai)
#pragma unroll
                for (int m = 0; m < 4; ++m) rs[ai][m] = row_ss_slot(SS, r00 + ai * 128 + m * 16, fq);
#pragma unroll
            for (int bj = 0; bj < 2; ++bj) { const int c = u.pn * 256 + bj * 128 + wc * 32 + 8 * fq; bv[bj][0] = *(const f32x4*)(BIAS + (size_t)mb * NINP + c); bv[bj][1] = *(const f32x4*)(BIAS + (size_t)mb * NINP + c + 4); }
#pragma unroll
            for (int ai = 0; ai < 2; ++ai)
#pragma unroll
                for (int m = 0; m < 4; ++m) rs[ai][m] = rstd_from_slot(rs[ai][m]);
            asm volatile("" ::: "memory");
#pragma unroll
            for (int ai = 0; ai < 2; ++ai)
#pragma unroll
                for (int m = 0; m < 4; ++m) {
                    const int r = r00 + ai * 128 + m * 16;
#pragma unroll
                    for (int bj = 0; bj < 2; ++bj) { const int colt = bj * 128 + wc * 32 + 8 * fq;
                        tile_store(acc[ai][bj][m][0] * rs[ai][m] + bv[bj][0], acc[ai][bj][m][1] * rs[ai][m] + bv[bj][1], u, r, colt, u.pn * 256 + colt); }
                }
        } else {
            EPI_ROWS_BEGIN
                const int mb = mbof(r); const float rstd = samp_rstd(SSS, r - MP);
#pragma unroll
                for (int bj = 0; bj < 2; ++bj) {
                    const int colt = bj * 128 + wc * 32 + 8 * fq, c = u.pn * 256 + colt;
                    const f32x4 b0 = *(const f32x4*)(BIAS + (size_t)mb * NINP + c), b1 = *(const f32x4*)(BIAS + (size_t)mb * NINP + c + 4);
                    tile_store(acc[ai][bj][m][0] * rstd + b0, acc[ai][bj][m][1] * rstd + b1, u, r, colt, c);
                }
            EPI_ROWS_END
        }
    }
};

struct EpiT1 {
    static constexpr bool PERM = true, AFTER_DRAIN = false;
    const bf16_t* ACT; float* T1;
    __device__ __forceinline__ void operator()(const Acc& acc, const pg8::Unit& u, int wr, int wc, int fr, int fq) const {
        const int cb0 = u.pn * 256 + wc * 32 + 8 * fq;
        u32x4 gb[2][2];
#define ET1_LOAD(g, par) do { const size_t r_ = (size_t)u.pm * 256 + ((g) >> 2) * 128 + wr * 64 + ((g) & 3) * 16 + fr; \
            gb[par][0] = *(const u32x4*)(ACT + r_ * NINP + CG + cb0); gb[par][1] = *(const u32x4*)(ACT + r_ * NINP + CG + cb0 + 128); } while (0)
        ET1_LOAD(0, 0);
#pragma unroll
        for (int g = 0; g < 8; ++g) {
            const int ai = g >> 2, m = g & 3;
            if (g + 1 < 8) ET1_LOAD(g + 1, (g + 1) & 1);
            __builtin_amdgcn_sched_barrier(0);
            const size_t r = (size_t)u.pm * 256 + ai * 128 + wr * 64 + m * 16 + fr;
#pragma unroll
            for (int bj = 0; bj < 2; ++bj) {
                const int c = cb0 + bj * 128; const u32x4 gw = gb[g & 1][bj];
                f32x4 o0, o1;
                o0[0] = sigmoidf_(blo(gw.x)) * acc[ai][bj][m][0][0]; o0[1] = sigmoidf_(bhi(gw.x)) * acc[ai][bj][m][0][1];
                o0[2] = sigmoidf_(blo(gw.y)) * acc[ai][bj][m][0][2]; o0[3] = sigmoidf_(bhi(gw.y)) * acc[ai][bj][m][0][3];
                o1[0] = sigmoidf_(blo(gw.z)) * acc[ai][bj][m][1][0]; o1[1] = sigmoidf_(bhi(gw.z)) * acc[ai][bj][m][1][1];
                o1[2] = sigmoidf_(blo(gw.w)) * acc[ai][bj][m][1][2]; o1[3] = sigmoidf_(bhi(gw.w)) * acc[ai][bj][m][1][3];
                *(f32x4*)(T1 + r * D + c) = o0; *(f32x4*)(T1 + r * D + c + 4) = o1;
            }
            __builtin_amdgcn_sched_barrier(0);
        }
#undef ET1_LOAD
    }
};
struct EpiMerge {
    static constexpr bool PERM = true, AFTER_DRAIN = false;
    const bf16_t* ACT; const float* T1; bf16_t* MG;
    __device__ __forceinline__ void operator()(const Acc& acc, const pg8::Unit& u, int wr, int wc, int fr, int fq) const {
        const int cb0 = u.pn * 256 + wc * 32 + 8 * fq;
        u32x4 gb[2][2]; f32x4 tb[2][4];
#define EMG_LOAD(g, par) do { const size_t r_ = (size_t)u.pm * 256 + ((g) >> 2) * 128 + wr * 64 + ((g) & 3) * 16 + fr; \
            gb[par][0] = *(const u32x4*)(ACT + r_ * NINP + CG + 1024 + cb0); gb[par][1] = *(const u32x4*)(ACT + r_ * NINP + CG + 1024 + cb0 + 128); \
            tb[par][0] = *(const f32x4*)(T1 + r_ * D + cb0); tb[par][1] = *(const f32x4*)(T1 + r_ * D + cb0 + 4); tb[par][2] = *(const f32x4*)(T1 + r_ * D + cb0 + 128); tb[par][3] = *(const f32x4*)(T1 + r_ * D + cb0 + 132); } while (0)
        EMG_LOAD(0, 0);
#pragma unroll
        for (int g = 0; g < 8; ++g) {
            const int ai = g >> 2, m = g & 3;
            if (g + 1 < 8) EMG_LOAD(g + 1, (g + 1) & 1);
            __builtin_amdgcn_sched_barrier(0);
            const size_t r = (size_t)u.pm * 256 + ai * 128 + wr * 64 + m * 16 + fr;
#pragma unroll
            for (int bj = 0; bj < 2; ++bj) {
                const int c = cb0 + bj * 128; const u32x4 gw = gb[g & 1][bj]; const f32x4 t0 = tb[g & 1][2 * bj], t1 = tb[g & 1][2 * bj + 1];
                f32x4 o0, o1;
                o0[0] = t0[0] + sigmoidf_(blo(gw.x)) * acc[ai][bj][m][0][0]; o0[1] = t0[1] + sigmoidf_(bhi(gw.x)) * acc[ai][bj][m][0][1];
                o0[2] = t0[2] + sigmoidf_(blo(gw.y)) * acc[ai][bj][m][0][2]; o0[3] = t0[3] + sigmoidf_(bhi(gw.y)) * acc[ai][bj][m][0][3];
                o1[0] = t1[0] + sigmoidf_(blo(gw.z)) * acc[ai][bj][m][1][0]; o1[1] = t1[1] + sigmoidf_(bhi(gw.z)) * acc[ai][bj][m][1][1];
                o1[2] = t1[2] + sigmoidf_(blo(gw.w)) * acc[ai][bj][m][1][2]; o1[3] = t1[3] + sigmoidf_(bhi(gw.w)) * acc[ai][bj][m][1][3];
                *(u32x4*)(MG + r * D + c) = pack8(o0, o1);
            }
            __builtin_amdgcn_sched_barrier(0);
        }
#undef EMG_LOAD
    }
};
template <bool WRITE_XG> struct EpiRes {
    static constexpr bool PERM = true, AFTER_DRAIN = false;
    const float* xres; const float* gate;
    float* XO; float* SSO; bf16_t* XG; const float* normg; const float* sc; LAS unsigned char* lds;
    __device__ __forceinline__ void operator()(const Acc& acc, const pg8::Unit& u, int wr, int wc, int fr, int fq) const {
        const int mb = u.pm >> 5;
        f32x4 gv[2][2], nv[2][2];
#pragma unroll
        for (int bj = 0; bj < 2; ++bj)
#pragma unroll
            for (int n = 0; n < 2; ++n) { const int c = u.pn * 256 + bj * 128 + wc * 32 + 8 * fq + 4 * n;
                gv[bj][n] = *(const f32x4*)(gate + (size_t)mb * 6144 + c);
                if (WRITE_XG) nv[bj][n] = *(const f32x4*)(normg + c) * (*(const f32x4*)(sc + (size_t)mb * 6144 + c) + 1.0f); }
        LAS float* xch = (LAS float*)(lds + LDS_XCH);
        f32x4 xb[2][4];
        const int cb0 = u.pn * 256 + wc * 32 + 8 * fq;
#define ERES_LOAD(g, par) do { const size_t r_ = (size_t)u.pm * 256 + ((g) >> 2) * 128 + wr * 64 + ((g) & 3) * 16 + fr; \
            xb[par][0] = *(const f32x4*)(xres + r_ * D + cb0); xb[par][1] = *(const f32x4*)(xres + r_ * D + cb0 + 4); \
            xb[par][2] = *(const f32x4*)(xres + r_ * D + cb0 + 128); xb[par][3] = *(const f32x4*)(xres + r_ * D + cb0 + 132); } while (0)
        ERES_LOAD(0, 0);
#pragma unroll
        for (int g = 0; g < 8; ++g) {
            const int ai = g >> 2, m = g & 3;
            if (g + 1 < 8) ERES_LOAD(g + 1, (g + 1) & 1);
            __builtin_amdgcn_sched_barrier(0);
            const int rl = ai * 128 + wr * 64 + m * 16 + fr; const size_t r = (size_t)u.pm * 256 + rl;
            float ss = 0.f;
#pragma unroll
            for (int bj = 0; bj < 2; ++bj) {
                const int c = cb0 + bj * 128;
                const f32x4 o0 = xb[g & 1][2 * bj] + gv[bj][0] * acc[ai][bj][m][0], o1 = xb[g & 1][2 * bj + 1] + gv[bj][1] * acc[ai][bj][m][1];
                *(f32x4*)(XO + r * D + c) = o0; *(f32x4*)(XO + r * D + c + 4) = o1;
                ss += (o0[0] * o0[0] + o0[1] * o0[1]) + (o0[2] * o0[2] + o0[3] * o0[3]) + (o1[0] * o1[0] + o1[1] * o1[1]) + (o1[2] * o1[2] + o1[3] * o1[3]);
                if (WRITE_XG) *(u32x4*)(XG + r * D + c) = pack8(o0 * nv[bj][0], o1 * nv[bj][1]);
            }
            ss += __shfl_xor(ss, 16); ss += __shfl_xor(ss, 32);
            if (fq == 0) xch[rl * 4 + wc] = ss;
            __builtin_amdgcn_sched_barrier(0);
        }
#undef ERES_LOAD
        asm volatile("s_waitcnt lgkmcnt(0)" ::: "memory"); __builtin_amdgcn_s_barrier(); asm volatile("" ::: "memory");
        if (wc == 0 && fq == 0) {
#pragma unroll
            for (int ai = 0; ai < 2; ++ai)
#pragma unroll
                for (int m = 0; m < 4; ++m) { const int rl = ai * 128 + wr * 64 + m * 16 + fr; const f32x4 p = *(const LAS f32x4*)(xch + rl * 4);
                    SSO[((size_t)u.pm * 256 + rl) * 4 + u.pn] = (p.x + p.y) + (p.z + p.w); }
        }
    }
};
struct EpiUp {
    static constexpr bool PERM = true, AFTER_DRAIN = false;
    bf16_t* U; const float* SS; const float* BIAS;
    __device__ __forceinline__ void operator()(const Acc& acc, const pg8::Unit& u, int wr, int wc, int fr, int fq) const {
        const int mb = u.pm >> 5, r00 = u.pm * 256 + wr * 64 + fr;
        f32x4 bv[2][2]; float rs[2][4];
#pragma unroll
        for (int ai = 0; ai < 2; ++ai)
#pragma unroll
            for (int m = 0; m < 4; ++m) rs[ai][m] = row_ss_slot(SS, r00 + ai * 128 + m * 16, fq);
#pragma unroll
        for (int bj = 0; bj < 2; ++bj) { const int c = u.pn * 256 + bj * 128 + wc * 32 + 8 * fq; bv[bj][0] = *(const f32x4*)(BIAS + (size_t)mb * DFF + c); bv[bj][1] = *(const f32x4*)(BIAS + (size_t)mb * DFF + c + 4); }
#pragma unroll
        for (int ai = 0; ai < 2; ++ai)
#pragma unroll
            for (int m = 0; m < 4; ++m) rs[ai][m] = rstd_from_slot(rs[ai][m]);
        asm volatile("" ::: "memory");
#pragma unroll
        for (int ai = 0; ai < 2; ++ai)
#pragma unroll
            for (int m = 0; m < 4; ++m) {
                const size_t r = (size_t)(r00 + ai * 128 + m * 16);
#pragma unroll
                for (int bj = 0; bj < 2; ++bj) {
                    const int c = u.pn * 256 + bj * 128 + wc * 32 + 8 * fq;
                    f32x4 v0 = acc[ai][bj][m][0] * rs[ai][m] + bv[bj][0], v1 = acc[ai][bj][m][1] * rs[ai][m] + bv[bj][1];
#pragma unroll
                    for (int i = 0; i < 4; ++i) { const float a = fmaxf(v0[i], 0.f), b = fmaxf(v1[i], 0.f); v0[i] = a * a; v1[i] = b * b; }
                    *(u32x4*)(U + r * DFF + c) = pack8(v0, v1);
                }
            }
    }
};

struct SchedG1 {
    pg8::StaticOrder so;
    __device__ void init(int G_, int c_) { so.init(MP, NINP, G_, c_); }
    __device__ bool next(int i, pg8::Unit& u) const {
        if (so.next(i, u)) return true;
        const long k = (long)i * so.G + so.c - so.nwg; if (k >= 0 && k < NINP / 256) { u.pm = 64; u.pn = (int)k; return true; }
        return false;
    }
    __device__ __forceinline__ void a_ready(const pg8::Unit&) const {}
    __device__ __forceinline__ void done(const pg8::Unit&) const {}
};

constexpr int NTHREADS = 512, NWAVES = 8;
constexpr int LDS_BYTES = 147456;
struct Args { const float* in[27]; float* out; unsigned char* ws; int ph_lo, ph_hi; };
static_assert(sizeof(Args) == 29 * 8 + 8, "no padding in Args");

struct Ctx {
    const Args& A; LAS unsigned char* lds; int tid, lane, wid, G, bid; float* out; unsigned char* ws;
    __device__ __forceinline__ const float* in(int k) const { return A.in[k]; }
};
__device__ __forceinline__ Ctx relaunder(const Ctx& X) {
    int w = X.wid, G = X.G, bid = X.bid; float* out = X.out; unsigned char* ws = X.ws; asm volatile("" : "+s"(w), "+s"(G), "+s"(bid));
    int ln; asm volatile("v_mbcnt_lo_u32_b32 %0, -1, 0\n\tv_mbcnt_hi_u32_b32 %0, -1, %0" : "=v"(ln));
    return Ctx{X.A, X.lds, w * 64 + ln, ln, w, G, bid, out, ws};
}
__device__ __forceinline__ const float* kvcache(const Ctx& X, int g) { return g == 0 ? X.in(2) : (g == 1 ? X.in(3) : X.in(4)); }
__device__ __forceinline__ size_t kvs_off(int g) { return g == 0 ? O_KVS0 : (g == 1 ? O_KVS1 : O_KVS2); }
__device__ __forceinline__ size_t kvp_off(int g) { return g == 0 ? O_KVP0 : (g == 1 ? O_KVP1 : O_KVP2); }
#define IN_X_P 0
#define IN_X_S 1
#define IN_KV0 2
#define IN_SSM 5
#define IN_CONV 6
#define IN_C_P 7
#define IN_C_S 8
#define IN_RELB 9
#define IN_WADA 10
#define IN_BADA 11
#define IN_N1G 12
#define IN_N2G 13
#define IN_WIN 14
#define IN_CONVW 15
#define IN_CONVB 16
#define IN_DTB 17
#define IN_ALOG 18
#define IN_DSKIP 19
#define IN_SSDG 20
#define IN_WOA 21
#define IN_WOS 22
#define IN_WOUT 23
#define IN_WUP 24
#define IN_WDN 25
#define IN_FING 26

template <bool SILU, class RowPtr>
__device__ __forceinline__ void skinny_item(const Ctx& X, RowPtr rp, const float* W, int ldw, int n0, int nvalid, const float* bvec, float* out, int ldo, int oc0) {
    LAS float* sl = (LAS float*)X.lds;
    float acc[NMB];
#pragma unroll
    for (int i = 0; i < NMB; ++i) acc[i] = 0.f;
    const bool valid = X.lane < nvalid;
    for (int half = 0; half < 2; ++half) {
        __syncthreads();
        for (int i = X.tid; i < NMB * 512; i += NTHREADS) { const int mb = i >> 9, kk = i & 511; float v = rp(mb)[half * 512 + kk]; if (SILU) v = siluf_(v); sl[i] = v; }
        __syncthreads();
        const int k0 = X.wid * 64;
        const float* wp = W + (size_t)(half * 512 + k0) * ldw + n0 + X.lane;
#define SK_LD4(dst, g) do { const int g_ = (g) < 16 ? (g) : 15; dst.x = valid ? wp[(size_t)(4 * g_ + 0) * ldw] : 0.f; dst.y = valid ? wp[(size_t)(4 * g_ + 1) * ldw] : 0.f; \
            dst.z = valid ? wp[(size_t)(4 * g_ + 2) * ldw] : 0.f; dst.w = valid ? wp[(size_t)(4 * g_ + 3) * ldw] : 0.f; } while (0)
        f32x4 wA, wB, wC, wD; SK_LD4(wA, 0); SK_LD4(wB, 1); SK_LD4(wC, 2);
#pragma unroll 1
        for (int g = 0; g < 16; ++g) {
            SK_LD4(wD, g + 3);
#pragma unroll
            for (int mb = 0; mb < NMB; ++mb) { const f32x4 sv = *(const LAS f32x4*)(sl + mb * 512 + k0 + 4 * g); acc[mb] += (sv.x * wA.x + sv.y * wA.y) + (sv.z * wA.z + sv.w * wA.w); }
            wA = wB; wB = wC; wC = wD;
        }
#undef SK_LD4
    }
    __syncthreads();
#pragma unroll
    for (int mb = 0; mb < NMB; ++mb) sl[(X.wid * NMB + mb) * 64 + X.lane] = acc[mb];
    __syncthreads();
    for (int o = X.tid; o < NMB * 64; o += NTHREADS) {
        const int mb = o >> 6, ln = o & 63; float s = 0.f;
#pragma unroll
        for (int w = 0; w < NWAVES; ++w) s += sl[(w * NMB + mb) * 64 + ln];
        if (ln < nvalid) out[(size_t)mb * ldo + oc0 + ln] = s + (bvec ? bvec[n0 + ln] : 0.f);
    }
    __syncthreads();
}

__device__ __forceinline__ void transpose_item(const float* W, int K, int N, bf16_t* WT, int k0, int n0, int drow0, LAS float* scr, int lane) {
#pragma unroll 8
    for (int i = 0; i < 32; ++i) { const int kk = 2 * i + (lane >> 5); scr[kk * 33 + (lane & 31)] = W[(size_t)(k0 + kk) * N + n0 + (lane & 31)]; }
    asm volatile("s_waitcnt lgkmcnt(0)" ::: "memory");
    const int c = lane & 7;
#pragma unroll
    for (int j = 0; j < 4; ++j) { const int n = (lane >> 3) + 8 * j; const LAS float* s = scr + (8 * c) * 33 + n;
        u32x4 o; o.x = cvt_pk_bf16(s[0 * 33], s[1 * 33]); o.y = cvt_pk_bf16(s[2 * 33], s[3 * 33]); o.z = cvt_pk_bf16(s[4 * 33], s[5 * 33]); o.w = cvt_pk_bf16(s[6 * 33], s[7 * 33]);
        *(u32x4*)(WT + (size_t)(drow0 + n) * K + k0 + 8 * c) = o; }
    asm volatile("s_waitcnt lgkmcnt(0)" ::: "memory");
}
__device__ __forceinline__ int win_dest_row(int n0) { return n0 < 8448 ? n0 : (n0 < 8480 ? CDT + (n0 - 8448) : n0 - 32); }

__device__ __forceinline__ int t5_bucket(int dist) {
    if (dist < 16) return dist;
    int large = 16 + (int)(logf((float)dist / 16.0f) / 4.852030263919617f * 16.0f);
    return large < 31 ? large : 31;
}

__device__ __forceinline__ void phase_p0a(const Ctx& X0) {
    const Ctx X = relaunder(X0);
    {
        const float* cp = X.in(IN_C_P); const float* cs = X.in(IN_C_S);
        auto rp = [=](int mb) { return mb < NBP ? cp + (size_t)mb * D : cs + (size_t)(mb - NBP) * D; };
        for (int it = X.bid; it < NLAYER * 96; it += X.G) {
            const int l = it / 96, cb = it % 96;
            skinny_item<true>(X, rp, X.in(IN_WADA) + (size_t)l * D * 6144, 6144, cb * 64, 64, X.in(IN_BADA) + (size_t)l * 6144,
                              (float*)(X.ws + WS_MOD) + (size_t)l * NMB * 6144, 6144, cb * 64);
        }
    }
    __syncthreads();
    {
        LAS float* scr = (LAS float*)(X.lds + X.wid * 8448);
        const int gw = X.bid * NWAVES + X.wid, NGW = X.G * NWAVES;
        constexpr int I_IN = 16 * 329, I_OA = 4 * 32, I_OS = 32 * 32, I_OUT = 16 * 32, I_UP = 16 * 128, I_DN = 64 * 32, I_L = I_IN + I_OA + I_OS + I_OUT + I_UP + I_DN;
        for (int it = gw; it < NLAYER * I_L; it += NGW) {
            const int l = it / I_L; int r = it % I_L;
            unsigned char* wl = X.ws + WS_W + (size_t)l * WL_SIZE;
            if (r < I_IN) { const int kb = r / 329, nb = r % 329; transpose_item(X.in(IN_WIN) + (size_t)l * D * NIN, D, NIN, (bf16_t*)(wl + WL_IN), kb * 64, nb * 32, win_dest_row(nb * 32), scr, X.lane); continue; } r -= I_IN;
            if (r < I_OA) { const int kb = r / 32, nb = r % 32; transpose_item(X.in(IN_WOA) + (size_t)l * 256 * D, 256, D, (bf16_t*)(wl + WL_OA), kb * 64, nb * 32, nb * 32, scr, X.lane); continue; } r -= I_OA;
            if (r < I_OS) { const int kb = r / 32, nb = r % 32; transpose_item(X.in(IN_WOS) + (size_t)l * DIN * D, DIN, D, (bf16_t*)(wl + WL_OS), kb * 64, nb * 32, nb * 32, scr, X.lane); continue; } r -= I_OS;
            if (r < I_OUT) { const int kb = r / 32, nb = r % 32; transpose_item(X.in(IN_WOUT) + (size_t)l * D * D, D, D, (bf16_t*)(wl + WL_OUT), kb * 64, nb * 32, nb * 32, scr, X.lane); continue; } r -= I_OUT;
            if (r < I_UP) { const int kb = r / 128, nb = r % 128; transpose_item(X.in(IN_WUP) + (size_t)l * D * DFF, D, DFF, (bf16_t*)(wl + WL_UP), kb * 64, nb * 32, nb * 32, scr, X.lane); continue; } r -= I_UP;
            { const int kb = r / 32, nb = r % 32; transpose_item(X.in(IN_WDN) + (size_t)l * DFF * D, DFF, D, (bf16_t*)(wl + WL_DN), kb * 64, nb * 32, nb * 32, scr, X.lane); }
        }
    }
    {
        const size_t gt = (size_t)X.bid * NTHREADS + X.tid, NT = (size_t)X.G * NTHREADS;
#pragma unroll
        for (int g = 0; g < 3; ++g) {
            const int Lb = 128 << (2 * g);
            const size_t nb4 = (size_t)(Lb - 1) * 128, blk4 = (size_t)Lb * 128, tot = 64 * nb4;
            const f32x4* src = (const f32x4*)kvcache(X, g); f32x4* dst = (f32x4*)(X.out + kvs_off(g));
            for (size_t i = gt; i < tot; i += NT) { const size_t blk = i / nb4, off = i - blk * nb4; __builtin_nontemporal_store(__builtin_nontemporal_load(src + blk * blk4 + 128 + off), dst + blk * blk4 + off); }
        }
    }
    if (X.bid == X.G - 1) {
        float* bt = (float*)(X.ws + WS_BTAB);
        for (int i = X.tid; i < 12 * 129; i += NTHREADS) { const int hd = i / 129, j = i % 129, g = hd >> 2; bt[hd * 132 + j] = X.in(IN_RELB)[t5_bucket(j << (2 * g)) * 12 + hd]; }
    }
}

__device__ __forceinline__ void phase_p0b(const Ctx& X0) {
    const Ctx X = relaunder(X0);
    const float* MOD = (const float*)(X.ws + WS_MOD);
    for (int it = X.bid; it < NLAYER * (168 + 64); it += X.G) {
        const int l = it / 232, r = it % 232;
        if (r < 168) {
            const int dc = r * 64; if (dc >= NIN) continue;
            const int sc = dc < 8448 ? dc : (dc < CDT ? dc + 32 : 8448 + (dc - CDT)); const int nv = dc < CDT ? 64 : 32;
            const float* mp = MOD + (size_t)l * NMB * 6144;
            auto rp = [=](int mb) { return mp + (size_t)mb * 6144; };
            skinny_item<false>(X, rp, X.in(IN_WIN) + (size_t)l * D * NIN, NIN, sc, nv, nullptr, (float*)(X.ws + WS_BIAS1) + (size_t)l * NMB * NINP, NINP, dc);
        } else {
            const int cb = r - 168;
            const float* mp = MOD + (size_t)l * NMB * 6144 + 3072;
            auto rp = [=](int mb) { return mp + (size_t)mb * 6144; };
            skinny_item<false>(X, rp, X.in(IN_WUP) + (size_t)l * D * DFF, DFF, cb * 64, 64, nullptr, (float*)(X.ws + WS_BIAS2) + (size_t)l * NMB * DFF, DFF, cb * 64);
        }
    }
    {
        const int gw = X.bid * NWAVES + X.wid, NGW = X.G * NWAVES;
        const float* ng = X.in(IN_N1G);
        for (int r = gw; r < MV; r += NGW) {
            const int mb = mbof(r);
            const float* xr = r < MP ? X.in(IN_X_P) + (size_t)r * D : X.in(IN_X_S) + (size_t)(r - MP) * D;
            const float* sc = MOD + (size_t)mb * 6144 + 1024;
            bf16_t* xo = (bf16_t*)(X.ws + WS_XG1) + (size_t)r * D;
            float ss = 0.f;
#pragma unroll
            for (int j = 0; j < 4; ++j) {
                const int c = 4 * X.lane + 256 * j;
                const f32x4 v = *(const f32x4*)(xr + c), g = *(const f32x4*)(ng + c), s = *(const f32x4*)(sc + c);
                ss += (v.x * v.x + v.y * v.y) + (v.z * v.z + v.w * v.w);
                const f32x4 y = v * g * (s + 1.0f);
                u32x2 w; w.x = cvt_pk_bf16(y.x, y.y); w.y = cvt_pk_bf16(y.z, y.w);
                *(u32x2*)(xo + c) = w;
            }
            ss = wave_sum(ss);
            if (r < MP) { if (X.lane < 4) ((float*)(X.ws + WS_SSA))[(size_t)r * 4 + X.lane] = X.lane == 0 ? ss : 0.f; }
            else ((float*)(X.ws + WS_SSSA))[(size_t)(r - MP) * 64 + X.lane] = X.lane == 0 ? ss : 0.f;
        }
    }
}

__device__ __forceinline__ void attn_microtile(const Ctx& X, int id, const LAS float* btab) {
    const bf16_t* ACT = (const bf16_t*)(X.ws + WS_ACT); const bf16_t* VT = (const bf16_t*)(X.ws + WS_VT);
    float* OG = (float*)(X.ws + WS_OG); float* LSE = (float*)(X.ws + WS_LSE);
    const int lane = X.lane, qi = lane & 15, kq = lane >> 4;
    int t = id; const int sub = t & 511; t >>= 9; const int hg = t & 3; t >>= 2; const int g = t % 3, b = t / 3;
    const int sh = 2 * g, ncl = 13 - sh;
    const int nsb = 1 << (ncl - 4);
    const int r = sub / nsb, s16 = sub % nsb;
    const int hd = 4 * g + hg, ilen = 1 << ncl;
    const int i0 = 16 * s16;
    const int tq = ((i0 + qi) << sh) + r;
    const size_t qrow = (size_t)(b * SEQ + tq) * NINP;
    bf16x8 qf[2];
#pragma unroll
    for (int ks = 0; ks < 2; ++ks) qf[ks] = *(const bf16x8*)(ACT + qrow + CQ + hd * 64 + 32 * ks + 8 * kq);
    f32x4 sc[10];
#pragma unroll
    for (int kt = 0; kt < 10; ++kt) {
        int ik = i0 - 128 + 16 * kt + qi; ik = ik < 0 ? 0 : (ik > ilen - 1 ? ilen - 1 : ik);
        const size_t krow = (size_t)(b * SEQ + (ik << sh) + r) * NINP + CK + hd * 64 + 8 * kq;
        const bf16x8 k0 = *(const bf16x8*)(ACT + krow), k1 = *(const bf16x8*)(ACT + krow + 32);
        f32x4 a = (f32x4){0.f, 0.f, 0.f, 0.f};
        a = MFMA16(k0, qf[0], a); a = MFMA16(k1, qf[1], a);
        sc[kt] = a;
    }
    const bf16_t* vbase = VT + ((size_t)((b * 12 + hd) * 64 + qi)) * SEQ + (size_t)r * ilen;
    u32x2 vfr[5][4][2];
#pragma unroll
    for (int ks2 = 0; ks2 < 5; ++ks2) {
        const int ia = i0 - 128 + 32 * ks2 + 4 * kq, ib = ia + 16;
        const bool oka = ia >= 0 && ia < ilen, okb = ib >= 0 && ib < ilen;
        const int iac = oka ? ia : 0, ibc = okb ? ib : 0;
#pragma unroll
        for (int dt = 0; dt < 4; ++dt) {
            const bf16_t* vp = vbase + (size_t)(16 * dt) * SEQ;
            const u32x2 va = *(const u32x2*)(vp + iac), vb = *(const u32x2*)(vp + ibc);
            vfr[ks2][dt][0] = oka ? va : (u32x2){0u, 0u}; vfr[ks2][dt][1] = okb ? vb : (u32x2){0u, 0u};
        }
    }
    float mx = -INFINITY;
#pragma unroll
    for (int kt = 0; kt < 10; ++kt)
#pragma unroll
        for (int e = 0; e < 4; ++e) {
            const int kk = 16 * kt + 4 * kq + e, j = 128 + qi - kk, ik = i0 - 128 + kk;
            const bool ok = (j >= 0) && (j <= 128) && (ik >= 0);
            const float s_ = ok ? sc[kt][e] * 0.125f + btab[hd * 132 + (ok ? j : 0)] : -INFINITY;
            sc[kt][e] = s_; mx = fmaxf(mx, s_);
        }
    mx = fmaxf(mx, __shfl_xor(mx, 16)); mx = fmaxf(mx, __shfl_xor(mx, 32));
    float l = 0.f;
#pragma unroll
    for (int kt = 0; kt < 10; ++kt)
#pragma unroll
        for (int e = 0; e < 4; ++e) { const float p = __expf(sc[kt][e] - mx); sc[kt][e] = p; l += p; }
    l += __shfl_xor(l, 16); l += __shfl_xor(l, 32);
    f32x4 o[4];
#pragma unroll
    for (int dt = 0; dt < 4; ++dt) o[dt] = (f32x4){0.f, 0.f, 0.f, 0.f};
#pragma unroll
    for (int ks2 = 0; ks2 < 5; ++ks2) {
        u32x4 pw; pw.x = cvt_pk_bf16(sc[2 * ks2][0], sc[2 * ks2][1]); pw.y = cvt_pk_bf16(sc[2 * ks2][2], sc[2 * ks2][3]);
        pw.z = cvt_pk_bf16(sc[2 * ks2 + 1][0], sc[2 * ks2 + 1][1]); pw.w = cvt_pk_bf16(sc[2 * ks2 + 1][2], sc[2 * ks2 + 1][3]);
        const bf16x8 pf = __builtin_bit_cast(bf16x8, pw);
#pragma unroll
        for (int dt = 0; dt < 4; ++dt) {
            u32x4 vw; vw.x = vfr[ks2][dt][0].x; vw.y = vfr[ks2][dt][0].y; vw.z = vfr[ks2][dt][1].x; vw.w = vfr[ks2][dt][1].y;
            o[dt] = MFMA16(__builtin_bit_cast(bf16x8, vw), pf, o[dt]);
        }
    }
    const float inv = 1.0f / l;
    const size_t orow = (size_t)(b * SEQ + tq);
    float* op = OG + ((size_t)g * M + orow) * 256 + hg * 64 + 4 * kq;
#pragma unroll
    for (int dt = 0; dt < 4; ++dt) *(f32x4*)(op + 16 * dt) = o[dt] * inv;
    if (kq == 0) LSE[((size_t)g * M + orow) * 4 + hg] = mx + __logf(l);
}

constexpr int XS_RS = 144, BS_RS = 272;
constexpr int L_XS = 0, L_BS = L_XS + 128 * XS_RS, L_CS = L_BS + 128 * BS_RS, L_HB = L_CS + 128 * BS_RS, L_FL = L_HB + 64 * BS_RS;
static_assert(L_FL + 400 * 4 <= 131072, "ssd lds");

__device__ __forceinline__ void ssd_passA_item(const Ctx& X, int layer, int item) {
    const int S = item & (NSC - 1), h = (item >> 3) & 31, b = item >> 8, gi = h >> 2;
    const bf16_t* XP = (const bf16_t*)(X.ws + WS_XBCP); const float* DT = (const float*)(X.ws + WS_DT);
    bf16_t* YL = (bf16_t*)(X.ws + WS_YL); float* ACUM = (float*)(X.ws + WS_ACUM);
    LAS unsigned char* lds = X.lds;
    LAS float* acs = (LAS float*)(lds + L_FL); LAS float* dtv = acs + 128; LAS float* wv = acs + 256; LAS float* misc = acs + 384;
    const int tid = X.tid, lane = X.lane, w = X.wid, l16 = lane & 15, kq = lane >> 4;
    const float A_h = -__expf(X.in(IN_ALOG)[layer * NH + h]), D_h = X.in(IN_DSKIP)[layer * NH + h];
    f32x4 Hacc[4];
#pragma unroll
    for (int pt = 0; pt < 4; ++pt) Hacc[pt] = (f32x4){0.f, 0.f, 0.f, 0.f};
    float abase = 0.f;
    const int cc = tid % 40, rs = tid / 40, r0 = rs * 11; const bool stager = tid < 480;
    const int scol = cc < 8 ? h * 64 + cc * 8 : (cc < 24 ? 2048 + gi * 128 + (cc - 8) * 8 : 3072 + gi * 128 + (cc - 24) * 8);
    const int rstride = cc < 8 ? XS_RS : BS_RS;
    LAS unsigned char* sdst = (cc < 8 ? lds + L_XS + cc * 16 : (cc < 24 ? lds + L_BS + (cc - 8) * 16 : lds + L_CS + (cc - 24) * 16)) + r0 * rstride;
    u32x4 raw[11]; float pd0 = 0.f, pd1 = 0.f;
#define SSD_PREFETCH(cidx) do { const size_t R0n = (size_t)b * SEQ + S * 1024 + (cidx) * 128; \
        if (stager) { const bf16_t* sp = XP + (R0n + r0) * 4096 + scol; \
            _Pragma("unroll") for (int q = 0; q < 11; ++q) { const int rq = (r0 + q < 128) ? q : 0; raw[q] = *(const u32x4*)(sp + (size_t)rq * 4096); } } \
        if (w == 0) { pd0 = DT[(R0n + 2 * lane) * 32 + h]; pd1 = DT[(R0n + 2 * lane + 1) * 32 + h]; } } while (0)
    __syncthreads();
    SSD_PREFETCH(0);
    for (int c = 0; c < 8; ++c) {
        const int T0 = S * 1024 + c * 128; const size_t R0 = (size_t)b * SEQ + T0;
#pragma unroll
        for (int pt = 0; pt < 4; ++pt)
#pragma unroll
            for (int e = 0; e < 4; ++e) *(LAS bf16_t*)(lds + L_HB + (16 * pt + 4 * kq + e) * BS_RS + (16 * w + l16) * 2) = (bf16_t)f2bf(Hacc[pt][e]);
        if (stager) {
#pragma unroll
            for (int q = 0; q < 11; ++q) if (r0 + q < 128) *(LAS u32x4*)(sdst + q * rstride) = raw[q];
        }
        if (w == 0) {
            const float d0 = pd0, d1 = pd1;
            const float a0 = d0 * A_h, a1 = d1 * A_h;
            float s_ = a0 + a1;
#pragma unroll
            for (int o = 1; o < 64; o <<= 1) { const float t = __shfl_up(s_, o); if (lane >= o) s_ += t; }
            const float c1 = s_, c0 = s_ - a1;
            const float tot = __shfl(s_, 63);
            acs[2 * lane] = c0; acs[2 * lane + 1] = c1; dtv[2 * lane] = d0; dtv[2 * lane + 1] = d1;
            wv[2 * lane] = d0 * __expf(tot - c0); wv[2 * lane + 1] = d1 * __expf(tot - c1);
            ACUM[(R0 + 2 * lane) * 32 + h] = abase + c0; ACUM[(R0 + 2 * lane + 1) * 32 + h] = abase + c1;
            if (lane == 0) misc[0] = __expf(tot);
            abase += tot;
        }
        __syncthreads();
        if (c + 1 < 8) SSD_PREFETCH(c + 1);
        const int lrow = 16 * w + l16;
        bf16x8 cf[4];
#pragma unroll
        for (int ks = 0; ks < 4; ++ks) cf[ks] = *(const LAS bf16x8*)(lds + L_CS + lrow * BS_RS + (32 * ks + 8 * kq) * 2);
        const float acl = acs[lrow];
        bf16x8 mf[4];
#pragma unroll
        for (int ks2 = 0; ks2 < 4; ++ks2) {
            unsigned pk[4];
#pragma unroll
            for (int hh = 0; hh < 2; ++hh) {
                const int st = 2 * ks2 + hh;
                pk[2 * hh] = 0u; pk[2 * hh + 1] = 0u;
                if (st <= w) {
                f32x4 gacc = (f32x4){0.f, 0.f, 0.f, 0.f};
#pragma unroll
                for (int ks = 0; ks < 4; ++ks) { const bf16x8 bfr = *(const LAS bf16x8*)(lds + L_BS + (16 * st + l16) * BS_RS + (32 * ks + 8 * kq) * 2); gacc = MFMA16(bfr, cf[ks], gacc); }
                const f32x4 as4 = *(const LAS f32x4*)(acs + 16 * st + 4 * kq), dt4 = *(const LAS f32x4*)(dtv + 16 * st + 4 * kq);
                float mv[4];
#pragma unroll
                for (int e = 0; e < 4; ++e) { const int s2 = 16 * st + 4 * kq + e; const float arg = (s2 <= lrow) ? acl - as4[e] : -INFINITY; mv[e] = gacc[e] * __expf(arg) * dt4[e]; }
                pk[2 * hh] = cvt_pk_bf16(mv[0], mv[1]); pk[2 * hh + 1] = cvt_pk_bf16(mv[2], mv[3]);
                }
            }
            u32x4 pw; pw.x = pk[0]; pw.y = pk[1]; pw.z = pk[2]; pw.w = pk[3];
            mf[ks2] = __builtin_bit_cast(bf16x8, pw);
        }
        f32x4 yd[4], yo[4];
#pragma unroll
        for (int pt = 0; pt < 4; ++pt) { yd[pt] = (f32x4){0.f, 0.f, 0.f, 0.f}; yo[pt] = (f32x4){0.f, 0.f, 0.f, 0.f}; }
        const int tq_ = l16 >> 2, tp_ = lane & 3;
#pragma unroll
        for (int ks2 = 0; ks2 < 4; ++ks2)
            if (2 * ks2 <= w)
#pragma unroll
            for (int pt = 0; pt < 4; ++pt) {
                const LAS unsigned char* xa = lds + L_XS + (32 * ks2 + 4 * kq + tq_) * XS_RS + (16 * pt + 4 * tp_) * 2;
                const s16x4 lo = tr16(xa), hi = tr16(xa + 16 * XS_RS);
                const bf16x8 xf = (bf16x8){lo[0], lo[1], lo[2], lo[3], hi[0], hi[1], hi[2], hi[3]};
                yd[pt] = MFMA16(xf, mf[ks2], yd[pt]);
            }
#pragma unroll
        for (int ks = 0; ks < 4; ++ks)
#pragma unroll
            for (int pt = 0; pt < 4; ++pt) { const bf16x8 hf = *(const LAS bf16x8*)(lds + L_HB + (16 * pt + l16) * BS_RS + (32 * ks + 8 * kq) * 2); yo[pt] = MFMA16(hf, cf[ks], yo[pt]); }
        {
            const float eal = __expf(acl);
            bf16_t* yp = YL + (R0 + lrow) * DIN + h * 64 + 4 * kq;
#pragma unroll
            for (int pt = 0; pt < 4; ++pt) {
                const u32x2 xw = *(const LAS u32x2*)(lds + L_XS + lrow * XS_RS + (16 * pt + 4 * kq) * 2);
                f32x4 xv; xv[0] = blo(xw.x); xv[1] = bhi(xw.x); xv[2] = blo(xw.y); xv[3] = bhi(xw.y);
                const f32x4 yv = yd[pt] + yo[pt] * eal + xv * D_h;
                u32x2 ow; ow.x = cvt_pk_bf16(yv[0], yv[1]); ow.y = cvt_pk_bf16(yv[2], yv[3]);
                *(u32x2*)(yp + 16 * pt) = ow;
            }
        }
        {
            const float dec = misc[0];
#pragma unroll
            for (int pt = 0; pt < 4; ++pt) Hacc[pt] = Hacc[pt] * dec;
#pragma unroll
            for (int ks = 0; ks < 4; ++ks) {
                const int lr0 = 32 * ks + 8 * kq;
                const LAS unsigned char* ba = lds + L_BS + (lr0 + tq_) * BS_RS + (16 * w + 4 * tp_) * 2;
                const s16x4 blo_ = tr16(ba), bhi_ = tr16(ba + 4 * BS_RS);
                const bf16x8 bfr = (bf16x8){blo_[0], blo_[1], blo_[2], blo_[3], bhi_[0], bhi_[1], bhi_[2], bhi_[3]};
                const f32x4 w0 = *(const LAS f32x4*)(wv + lr0), w1 = *(const LAS f32x4*)(wv + lr0 + 4);
#pragma unroll
                for (int pt = 0; pt < 4; ++pt) {
                    const LAS unsigned char* xa = lds + L_XS + (lr0 + tq_) * XS_RS + (16 * pt + 4 * tp_) * 2;
                    const s16x4 lo = tr16(xa), hi = tr16(xa + 4 * XS_RS);
                    u32x4 xw;
                    xw.x = cvt_pk_bf16(bf2f((unsigned short)lo[0]) * w0[0], bf2f((unsigned short)lo[1]) * w0[1]); xw.y = cvt_pk_bf16(bf2f((unsigned short)lo[2]) * w0[2], bf2f((unsigned short)lo[3]) * w0[3]);
                    xw.z = cvt_pk_bf16(bf2f((unsigned short)hi[0]) * w1[0], bf2f((unsigned short)hi[1]) * w1[1]); xw.w = cvt_pk_bf16(bf2f((unsigned short)hi[2]) * w1[2], bf2f((unsigned short)hi[3]) * w1[3]);
                    Hacc[pt] = MFMA16(__builtin_bit_cast(bf16x8, xw), bfr, Hacc[pt]);
                }
            }
        }
        __syncthreads();
    }
#undef SSD_PREFETCH
    {
        float* hl = (float*)(X.ws + WS_HLOC) + ((size_t)((b * NH + h) * NSC + S)) * 8192;
#pragma unroll
        for (int pt = 0; pt < 4; ++pt)
#pragma unroll
            for (int e = 0; e < 4; ++e) hl[(16 * pt + 4 * kq + e) * 128 + 16 * w + l16] = Hacc[pt][e];
        if (w == 0 && lane == 0) ((float*)(X.ws + WS_ATOT))[(b * NH + h) * NSC + S] = abase;
    }
}

__device__ __forceinline__ void conv_prepass(const Ctx& X, int layer) {
    const bf16_t* ACT = (const bf16_t*)(X.ws + WS_ACT); bf16_t* XP = (bf16_t*)(X.ws + WS_XBCP);
    const float* cwp = X.in(IN_CONVW) + (size_t)layer * 4 * 4096; const float* cbp = X.in(IN_CONVB) + (size_t)layer * 4096;
    const int gw = X.bid * NWAVES + X.wid, NGW = X.G * NWAVES;
    for (int task = gw; task < 8 * NBP * (SEQ / 64); task += NGW) {
        const int cg = task & 7, run = task >> 3, b = run >> 7, T0 = (run & 127) * 64;
        const int ch = cg * 512 + X.lane * 8;
        float cw[5][8];
#pragma unroll
        for (int t = 0; t < 5; ++t) { const float* p = t < 4 ? cwp + t * 4096 + ch : cbp + ch; const f32x4 a = *(const f32x4*)p, bq = *(const f32x4*)(p + 4);
            cw[t][0] = a[0]; cw[t][1] = a[1]; cw[t][2] = a[2]; cw[t][3] = a[3]; cw[t][4] = bq[0]; cw[t][5] = bq[1]; cw[t][6] = bq[2]; cw[t][7] = bq[3]; }
        const bf16_t* src = ACT + ((size_t)b * SEQ) * NINP + CX + ch; bf16_t* dst = XP + ((size_t)b * SEQ) * 4096 + ch;
        u32x4 win[11];
        u32x4 nxt[8];
#pragma unroll
        for (int t = 0; t < 3; ++t) { const int tt = T0 - 3 + t; win[t] = tt >= 0 ? *(const u32x4*)(src + (size_t)tt * NINP) : (u32x4){0u, 0u, 0u, 0u}; }
#pragma unroll
        for (int t = 0; t < 8; ++t) win[3 + t] = *(const u32x4*)(src + (size_t)(T0 + t) * NINP);
#pragma unroll 1
        for (int blk = 0; blk < 8; ++blk) {
            const int tb = T0 + 8 * blk;
            if (blk < 7) {
#pragma unroll
                for (int t = 0; t < 8; ++t) nxt[t] = *(const u32x4*)(src + (size_t)(tb + 8 + t) * NINP);
            }
#pragma unroll
            for (int q = 0; q < 8; ++q) {
                float y[8];
#pragma unroll
                for (int i = 0; i < 8; ++i) {
                    float acc = cw[4][i];
#pragma unroll
                    for (int t = 0; t < 4; ++t) { const unsigned wd = win[q + t][i >> 1]; acc += ((i & 1) ? bhi(wd) : blo(wd)) * cw[t][i]; }
                    y[i] = siluf_(acc);
                }
                u32x4 o; o.x = cvt_pk_bf16(y[0], y[1]); o.y = cvt_pk_bf16(y[2], y[3]); o.z = cvt_pk_bf16(y[4], y[5]); o.w = cvt_pk_bf16(y[6], y[7]);
                *(u32x4*)(dst + (size_t)(tb + q) * 4096) = o;
            }
            win[0] = win[8]; win[1] = win[9]; win[2] = win[10];
#pragma unroll
            for (int t = 0; t < 8; ++t) win[3 + t] = nxt[t];
        }
    }
}

__device__ __forceinline__ void sample_attn_wave(const Ctx& X, int layer, int id, const LAS float* btab) {
    const int g = id % 3, bh = id / 3, hg = bh & 3, b = bh >> 2;
    const bf16_t* ACT = (const bf16_t*)(X.ws + WS_ACT);
    LAS float* q = (LAS float*)(X.lds + 8192 + X.wid * 1024); LAS float* p = q + 64;
    const int lane = X.lane;
    const size_t arow = (size_t)(MP + b) * NINP;
    const int sh = 2 * g, Lb = 128 << sh, hd = 4 * g + hg;
    const float* cache = kvcache(X, g) + ((size_t)(layer * NBS + b) * Lb) * 512;
    const float knew = bf2f(ACT[arow + CK + hd * 64 + lane]), vnew = bf2f(ACT[arow + CV + hd * 64 + lane]);
    q[lane] = bf2f(ACT[arow + CQ + hd * 64 + lane]);
    { float* orow = X.out + kvs_off(g) + ((size_t)(layer * NBS + b) * Lb + (Lb - 1)) * 512; orow[hg * 64 + lane] = knew; orow[256 + hg * 64 + lane] = vnew; }
    float s[3];
    const float s0 = wave_sum(q[lane] * knew);
#pragma unroll
    for (int rnd = 0; rnd < 3; ++rnd) {
        const int j = rnd * 64 + lane; float acc = 0.f;
        if (j >= 1 && j <= 128) {
            const float* kr = cache + (size_t)(Lb - (j << sh)) * 512 + hg * 64;
#pragma unroll
            for (int d4 = 0; d4 < 16; ++d4) { const f32x4 kv = *(const f32x4*)(kr + 4 * d4); const f32x4 qv = *(const LAS f32x4*)(q + 4 * d4); acc += (kv.x * qv.x + kv.y * qv.y) + (kv.z * qv.z + kv.w * qv.w); }
        }
        if (j == 0) acc = s0;
        s[rnd] = (j <= 128) ? acc * 0.125f + btab[hd * 132 + (j <= 128 ? j : 0)] : -INFINITY;
    }
    const float mx = wave_max(fmaxf(fmaxf(s[0], s[1]), s[2]));
    float l = 0.f;
#pragma unroll
    for (int rnd = 0; rnd < 3; ++rnd) { const int j = rnd * 64 + lane; const float pv = __expf(s[rnd] - mx); if (j <= 128) { p[j] = pv; l += pv; } }
    l = wave_sum(l);
    asm volatile("s_waitcnt lgkmcnt(0)" ::: "memory");
    float o = p[0] * vnew;
    const float* vb = cache + 256 + hg * 64 + lane;
#pragma unroll 32
    for (int j = 1; j <= 128; ++j) o += p[j] * vb[(size_t)(Lb - (j << sh)) * 512];
    const size_t orow = (size_t)MP + b;
    ((float*)(X.ws + WS_OG))[((size_t)g * M + orow) * 256 + hg * 64 + lane] = o / l;
    if (lane == 0) ((float*)(X.ws + WS_LSE))[((size_t)g * M + orow) * 4 + hg] = mx + __logf(l);
}

__device__ __forceinline__ void sample_ssd_item(const Ctx& X, int layer, int item) {
    const int b = item >> 3, gi = item & 7;
    const bf16_t* ACT = (const bf16_t*)(X.ws + WS_ACT); const float* DT = (const float*)(X.ws + WS_DT);
    LAS float* xs = (LAS float*)(X.lds + 16384); LAS float* Bs = xs + 256; LAS float* Cs = Bs + 128; LAS float* ys = Cs + 128; LAS float* red = ys + 256;
    const int tid = X.tid, lane = X.lane, w = X.wid;
    const size_t arow = (size_t)(MP + b) * NINP;
    __syncthreads();
    {
        const int ch = tid < 256 ? gi * 256 + tid : (tid < 384 ? 2048 + gi * 128 + (tid - 256) : 3072 + gi * 128 + (tid - 384));
        const float* st = X.in(IN_CONV) + ((size_t)(layer * NBS + b) * 3) * 4096 + ch;
        const float* cwp = X.in(IN_CONVW) + (size_t)layer * 4 * 4096 + ch;
        const float s0 = st[0], s1 = st[4096], s2 = st[8192], xr = bf2f(ACT[arow + CX + ch]);
        const float y = siluf_(X.in(IN_CONVB)[layer * 4096 + ch] + s0 * cwp[0] + s1 * cwp[4096] + s2 * cwp[8192] + xr * cwp[12288]);
        xs[tid] = y;
        float* co = X.out + O_CONVS + ((size_t)(layer * NBS + b) * 3) * 4096 + ch;
        co[0] = s1; co[4096] = s2; co[8192] = xr;
    }
    __syncthreads();
    {
        const int e = w >> 1, h = gi * 4 + e, half = lane >> 5, n4 = (lane & 31) * 4;
        const float dt = DT[(size_t)(MP + b) * 32 + h], A_h = -__expf(X.in(IN_ALOG)[layer * NH + h]), D_h = X.in(IN_DSKIP)[layer * NH + h];
        const float dA = __expf(dt * A_h);
        const f32x4 Bv = *(const LAS f32x4*)(Bs + n4), Cv = *(const LAS f32x4*)(Cs + n4);
        const float* hin = X.in(IN_SSM) + ((size_t)((layer * NBS + b) * NH + h)) * 8192;
        float* hout = X.out + O_SSMS + ((size_t)((layer * NBS + b) * NH + h)) * 8192;
#pragma unroll 8
        for (int it = 0; it < 16; ++it) {
            const int p = 32 * (w & 1) + 2 * it + half;
            const float xp = xs[e * 64 + p];
            const f32x4 hv = *(const f32x4*)(hin + p * 128 + n4);
            const f32x4 hn = hv * dA + Bv * (dt * xp);
            *(f32x4*)(hout + p * 128 + n4) = hn;
            float y = (hn.x * Cv.x + hn.y * Cv.y) + (hn.z * Cv.z + hn.w * Cv.w);
            y += __shfl_xor(y, 1); y += __shfl_xor(y, 2); y += __shfl_xor(y, 4); y += __shfl_xor(y, 8); y += __shfl_xor(y, 16);
            if ((lane & 31) == 0) ys[e * 64 + p] = y + D_h * xp;
        }
    }
    __syncthreads();
    if (tid < 256) {
        const float z = bf2f(ACT[arow + CZ + gi * 256 + tid]);
        const float gv = ys[tid] * siluf_(z);
        float ss = wave_sum(gv * gv);
        if (lane == 0) red[w] = ss;
        ys[tid] = gv;
    }
    __syncthreads();
    if (tid < 256) {
        const float tot = red[0] + red[1] + red[2] + red[3];
        const float rstd = rsqrtf(tot * (1.0f / 256.0f) + EPS);
        ((bf16_t*)(X.ws + WS_SSDN))[(size_t)(MP + b) * DIN + gi * 256 + tid] = (bf16_t)f2bf(ys[tid] * rstd * X.in(IN_SSDG)[layer * DIN + gi * 256 + tid]);
    }
}

__device__ __forceinline__ void phase_p2a(const Ctx& X0, int layer) {
    const Ctx X = relaunder(X0);
    LAS float* btab = (LAS float*)X.lds;
    __syncthreads();
    for (int i = X.tid; i < 12 * 132; i += NTHREADS) btab[i] = ((const float*)(X.ws + WS_BTAB))[i];
    __syncthreads();
    for (int rep = 0; rep < 1 + ((P2REP >> 0) & 1); ++rep) {
    { const int gw = X.wid * X.G + X.bid, NGW = X.G * NWAVES; for (int id = gw; id < NBS * 12; id += NGW) sample_attn_wave(X, layer, id, btab); }
    for (int it = X.bid; it < NBS * 8; it += X.G) sample_ssd_item(X, layer, it);
    }
    for (int rep = 0; rep < 1 + ((P2REP >> 1) & 1); ++rep) conv_prepass(X, layer);
    for (int rep = 0; rep < 1 + ((P2REP >> 2) & 1); ++rep) for (int bw = X.bid; bw < 1536; bw += X.G) attn_microtile(X, bw * 8 + X.wid, btab);
}
__device__ __forceinline__ void phase_p2b(const Ctx& X0, int layer) {
    const Ctx X = relaunder(X0);
    for (int rep = 0; rep < 1 + ((P2REP >> 3) & 1); ++rep) { __syncthreads(); for (int it = X.bid; it < NBP * NH * NSC; it += X.G) ssd_passA_item(X, layer, it); }
}

constexpr int HIN_RS = 272;
__device__ __forceinline__ void passB_item(const Ctx& X, int layer, int item) {
    const int half = item & 1, gi = (item >> 1) & 7, S = (item >> 4) & 7, b = item >> 7;
    const bf16_t* ACT = (const bf16_t*)(X.ws + WS_ACT); const bf16_t* XP = (const bf16_t*)(X.ws + WS_XBCP);
    const bf16_t* YL = (const bf16_t*)(X.ws + WS_YL); const float* ACUM = (const float*)(X.ws + WS_ACUM); const float* ATOT = (const float*)(X.ws + WS_ATOT);
    const float* HLOC = (const float*)(X.ws + WS_HLOC);
    LAS unsigned char* lds = X.lds;
    const int tid = X.tid, lane = X.lane, w = X.wid, l16 = lane & 15, kq = lane >> 4;
    __syncthreads();
    if (S > 0) {
#pragma unroll
        for (int e = 0; e < 4; ++e) {
            const int h = gi * 4 + e; const float* at = ATOT + (b * NH + h) * NSC; const float* hl = HLOC + ((size_t)(b * NH + h) * NSC) * 8192;
            f32x4 a[4];
#pragma unroll
            for (int i = 0; i < 4; ++i) a[i] = (f32x4){0.f, 0.f, 0.f, 0.f};
            float lg = 0.f;
            for (int sp = S - 1; sp >= 0; --sp) {
                const float wgt = __expf(lg);
                if (wgt == 0.f) break;
#pragma unroll
                for (int i = 0; i < 4; ++i) a[i] += *(const f32x4*)(hl + (size_t)sp * 8192 + (i * 512 + tid) * 4) * wgt;
                lg += at[sp];
            }
#pragma unroll
            for (int i = 0; i < 4; ++i) { const int idx = (i * 512 + tid) * 4, p = idx >> 7, n = idx & 127;
                u32x2 o; o.x = cvt_pk_bf16(a[i][0], a[i][1]); o.y = cvt_pk_bf16(a[i][2], a[i][3]);
                *(LAS u32x2*)(lds + (e * 64 + p) * HIN_RS + n * 2) = o; }
        }
    }
    __syncthreads();
    const float* ng = X.in(IN_SSDG) + (size_t)layer * DIN;
#pragma unroll 1
    for (int cc = 0; cc < 4; ++cc) {
        const int c = S * 8 + half * 4 + cc;
        const size_t row = (size_t)b * SEQ + c * 128 + 16 * w + l16;
        bf16x8 cf[4]; u32x2 ylw[4][4], zw[4][4]; float ac[4];
        if (S > 0) {
#pragma unroll
            for (int ks = 0; ks < 4; ++ks) cf[ks] = *(const bf16x8*)(XP + row * 4096 + 3072 + gi * 128 + 32 * ks + 8 * kq);
        }
#pragma unroll
        for (int e = 0; e < 4; ++e) {
            ac[e] = ACUM[row * 32 + gi * 4 + e];
#pragma unroll
            for (int pt = 0; pt < 4; ++pt) { const int col = (gi * 4 + e) * 64 + 16 * pt + 4 * kq; ylw[e][pt] = *(const u32x2*)(YL + row * DIN + col); zw[e][pt] = *(const u32x2*)(ACT + row * NINP + CZ + col); }
        }
        f32x4 acc[4][4];
#pragma unroll
        for (int e = 0; e < 4; ++e)
#pragma unroll
            for (int pt = 0; pt < 4; ++pt) acc[e][pt] = (f32x4){0.f, 0.f, 0.f, 0.f};
        if (S > 0) {
#pragma unroll
            for (int ks = 0; ks < 4; ++ks)
#pragma unroll
                for (int e = 0; e < 4; ++e)
#pragma unroll
                    for (int pt = 0; pt < 4; ++pt) { const bf16x8 hf = *(const LAS bf16x8*)(lds + (e * 64 + 16 * pt + l16) * HIN_RS + (32 * ks + 8 * kq) * 2); acc[e][pt] = MFMA16(hf, cf[ks], acc[e][pt]); }
        }
        float ss = 0.f;
#pragma unroll
        for (int e = 0; e < 4; ++e) {
            const float ea = S > 0 ? __expf(ac[e]) : 0.f;
#pragma unroll
            for (int pt = 0; pt < 4; ++pt) {
                f32x4 yl; yl[0] = blo(ylw[e][pt].x); yl[1] = bhi(ylw[e][pt].x); yl[2] = blo(ylw[e][pt].y); yl[3] = bhi(ylw[e][pt].y);
                f32x4 y = yl + acc[e][pt] * ea;
                y[0] *= siluf_(blo(zw[e][pt].x)); y[1] *= siluf_(bhi(zw[e][pt].x)); y[2] *= siluf_(blo(zw[e][pt].y)); y[3] *= siluf_(bhi(zw[e][pt].y));
                ss += (y[0] * y[0] + y[1] * y[1]) + (y[2] * y[2] + y[3] * y[3]);
                acc[e][pt] = y;
            }
        }
        ss += __shfl_xor(ss, 16); ss += __shfl_xor(ss, 32);
        const float rstd = rsqrtf(ss * (1.0f / 256.0f) + EPS);
        bf16_t* so = (bf16_t*)(X.ws + WS_SSDN) + row * DIN;
#pragma unroll
        for (int e = 0; e < 4; ++e)
#pragma unroll
            for (int pt = 0; pt < 4; ++pt) {
                const int col = (gi * 4 + e) * 64 + 16 * pt + 4 * kq;
                const f32x4 g = *(const f32x4*)(ng + col); const f32x4 y = acc[e][pt] * rstd * g;
                u32x2 o; o.x = cvt_pk_bf16(y[0], y[1]); o.y = cvt_pk_bf16(y[2], y[3]);
                *(u32x2*)(so + col) = o;
            }
    }
}

__device__ __forceinline__ void phase_p3(const Ctx& X0, int layer) {
    const Ctx X = relaunder(X0);
    for (int it = X.bid; it < NBP * NSC * 8 * 2; it += X.G) passB_item(X, layer, it);
    {
        const float* ATOT = (const float*)(X.ws + WS_ATOT); const float* HLOC = (const float*)(X.ws + WS_HLOC);
        for (int it = X.bid; it < NBP * NH; it += X.G) {
            const float* at = ATOT + it * NSC; const float* hl = HLOC + (size_t)it * NSC * 8192;
            f32x4 a[4];
#pragma unroll
            for (int i = 0; i < 4; ++i) a[i] = (f32x4){0.f, 0.f, 0.f, 0.f};
            float lg = 0.f;
            for (int sp = NSC - 1; sp >= 0; --sp) {
                const float wgt = __expf(lg);
                if (wgt == 0.f) break;
#pragma unroll
                for (int i = 0; i < 4; ++i) a[i] += *(const f32x4*)(hl + (size_t)sp * 8192 + (i * 512 + X.tid) * 4) * wgt;
                lg += at[sp];
            }
            float* o = X.out + O_SSMP + ((size_t)layer * NBP * NH + it) * 8192;
#pragma unroll
            for (int i = 0; i < 4; ++i) *(f32x4*)(o + (i * 512 + X.tid) * 4) = a[i];
        }
    }
    const int gw = X.bid * NWAVES + X.wid, NGW = X.G * NWAVES, lane = X.lane;
    {
        const float* OG = (const float*)(X.ws + WS_OG); const float* LSE = (const float*)(X.ws + WS_LSE); bf16_t* AT = (bf16_t*)(X.ws + WS_ATTN);
        for (int row = gw; row < MV; row += NGW) {
            const int hg = lane >> 4;
            const float l0 = LSE[((size_t)0 * M + row) * 4 + hg], l1 = LSE[((size_t)1 * M + row) * 4 + hg], l2 = LSE[((size_t)2 * M + row) * 4 + hg];
            const float mm = fmaxf(l0, fmaxf(l1, l2)); const float e0 = __expf(l0 - mm), e1 = __expf(l1 - mm), e2 = __expf(l2 - mm); const float inv = 1.0f / (e0 + e1 + e2);
            const f32x4 a = *(const f32x4*)(OG + ((size_t)0 * M + row) * 256 + 4 * lane), bq = *(const f32x4*)(OG + ((size_t)1 * M + row) * 256 + 4 * lane), cq = *(const f32x4*)(OG + ((size_t)2 * M + row) * 256 + 4 * lane);
            const f32x4 v = (a * e0 + bq * e1 + cq * e2) * inv;
            u32x2 o; o.x = cvt_pk_bf16(v[0], v[1]); o.y = cvt_pk_bf16(v[2], v[3]);
            *(u32x2*)(AT + (size_t)row * 256 + 4 * lane) = o;
        }
    }
    {
        const bf16_t* ACT = (const bf16_t*)(X.ws + WS_ACT);
        for (int it = gw; it < 10752; it += NGW) {
            int g, r = it; if (r < 512) g = 0; else if (r < 2560) { g = 1; r -= 512; } else { g = 2; r -= 2560; }
            const int win = 128 << (2 * g), kv = r & 1, i = (r >> 1) % win, b = (r >> 1) / win;
            const size_t arow = ((size_t)b * SEQ + (SEQ - win + i)) * NINP + (kv ? CV : CK) + g * 256 + 4 * lane;
            const u32x2 v = *(const u32x2*)(ACT + arow);
            f32x4 o; o[0] = blo(v.x); o[1] = bhi(v.x); o[2] = blo(v.y); o[3] = bhi(v.y);
            *(f32x4*)(X.out + kvp_off(g) + ((((size_t)layer * NBP + b) * win + i) * 2 + kv) * 256 + 4 * lane) = o;
        }
        for (int it = gw; it < NBP * 3 * 16; it += NGW) {
            const int pc = it & 15, i = (it >> 4) % 3, b = it / 48;
            const u32x2 v = *(const u32x2*)(ACT + ((size_t)b * SEQ + SEQ - 3 + i) * NINP + CX + pc * 256 + 4 * lane);
            f32x4 o; o[0] = blo(v.x); o[1] = bhi(v.x); o[2] = blo(v.y); o[3] = bhi(v.y);
            *(f32x4*)(X.out + O_CONVP + (((size_t)layer * NBP + b) * 3 + i) * 4096 + pc * 256 + 4 * lane) = o;
        }
    }
}

__device__ __forceinline__ void phase_final(const Ctx& X0) {
    const Ctx X = relaunder(X0);
    const int gw = X.bid * NWAVES + X.wid, NGW = X.G * NWAVES, lane = X.lane;
    const float* XA = (const float*)(X.ws + WS_XA); const float* SS = (const float*)(X.ws + WS_SSA); const float* fg = X.in(IN_FING);
    for (int r = gw; r < MV; r += NGW) {
        const float rstd = r < MP ? row_rstd(SS, r) : samp_rstd((const float*)(X.ws + WS_SSSA), r - MP);
        float* o = r < MP ? X.out + O_YP + (size_t)r * D : X.out + O_YS + (size_t)(r - MP) * D;
#pragma unroll
        for (int j = 0; j < 4; ++j) { const int c = 4 * lane + 256 * j; *(f32x4*)(o + c) = *(const f32x4*)(XA + (size_t)r * D + c) * rstd * *(const f32x4*)(fg + c); }
    }
}


__device__ __forceinline__ void sk_accum(f32x4 (&acc)[2], const bf16_t* A, int lda, const bf16_t* Bt, int K, int wid, int lane) {
    const int r16 = lane & 15, kq = lane >> 4, kper = K >> 3, k0 = wid * kper + 8 * kq;
    const bf16_t* ap0 = A + (size_t)r16 * lda + k0; const bf16_t* ap1 = ap0 + (size_t)16 * lda; const bf16_t* bp = Bt + (size_t)r16 * K + k0;
#pragma unroll 4
    for (int ks = 0; ks < kper; ks += 32) {
        const bf16x8 bfr = *(const bf16x8*)(bp + ks), a0 = *(const bf16x8*)(ap0 + ks), a1 = *(const bf16x8*)(ap1 + ks);
        acc[0] = MFMA16(bfr, a0, acc[0]); acc[1] = MFMA16(bfr, a1, acc[1]);
    }
}
__device__ __forceinline__ f32x4 sk_reduce(LAS unsigned char* lds, int off, const f32x4 (&acc)[2], int wid, int lane) {
    LAS f32x4* red = (LAS f32x4*)(lds + off);
    red[(wid * 2 + 0) * 64 + lane] = acc[0]; red[(wid * 2 + 1) * 64 + lane] = acc[1];
    __syncthreads();
    f32x4 s = (f32x4){0.f, 0.f, 0.f, 0.f};
    if (wid < 2) {
#pragma unroll
        for (int w = 0; w < 8; ++w) s += red[(w * 2 + wid) * 64 + lane];
    }
    return s;
}
__device__ __forceinline__ void samp_g4(const Ctx& X, int layer) {
    unsigned char* ws = X.ws; unsigned char* wl = ws + WS_W + (size_t)layer * WL_SIZE;
    for (int it = X.bid; it < 64; it += X.G) {
        const int col0 = it * 16;
        f32x4 aa[2] = {(f32x4){0.f, 0.f, 0.f, 0.f}, (f32x4){0.f, 0.f, 0.f, 0.f}}, as[2] = {(f32x4){0.f, 0.f, 0.f, 0.f}, (f32x4){0.f, 0.f, 0.f, 0.f}};
        sk_accum(aa, (const bf16_t*)(ws + WS_ATTN) + (size_t)MP * 256, 256, (const bf16_t*)(wl + WL_OA) + (size_t)col0 * 256, 256, X.wid, X.lane);
        sk_accum(as, (const bf16_t*)(ws + WS_SSDN) + (size_t)MP * DIN, DIN, (const bf16_t*)(wl + WL_OS) + (size_t)col0 * DIN, DIN, X.wid, X.lane);
        __syncthreads();
        const f32x4 va = sk_reduce(X.lds, 0, aa, X.wid, X.lane);
        const f32x4 vs = sk_reduce(X.lds, 16384, as, X.wid, X.lane);
        if (X.wid < 2) {
            const int t = 16 * X.wid + (X.lane & 15), c = col0 + 4 * (X.lane >> 4); const size_t r = (size_t)MP + t;
            const bf16_t* act = (const bf16_t*)(ws + WS_ACT) + r * NINP + CG + c;
            const u32x2 ga = *(const u32x2*)act, gs = *(const u32x2*)(act + 1024);
            f32x4 o;
            o[0] = sigmoidf_(blo(ga.x)) * va[0] + sigmoidf_(blo(gs.x)) * vs[0]; o[1] = sigmoidf_(bhi(ga.x)) * va[1] + sigmoidf_(bhi(gs.x)) * vs[1];
            o[2] = sigmoidf_(blo(ga.y)) * va[2] + sigmoidf_(blo(gs.y)) * vs[2]; o[3] = sigmoidf_(bhi(ga.y)) * va[3] + sigmoidf_(bhi(gs.y)) * vs[3];
            u32x2 w; w.x = cvt_pk_bf16(o[0], o[1]); w.y = cvt_pk_bf16(o[2], o[3]);
            *(u32x2*)((bf16_t*)(ws + WS_MERGED) + r * D + c) = w;
        }
        __syncthreads();
    }
}
__device__ __forceinline__ void samp_res(const Ctx& X, const bf16_t* A, int K, const bf16_t* Bt, const float* xres  , const float* gate  ,
                                         float* XO  , float* SSS, bf16_t* XG  , const float* normg, const float* sc) {
    for (int it = X.bid; it < 64; it += X.G) {
        const int col0 = it * 16;
        f32x4 a[2] = {(f32x4){0.f, 0.f, 0.f, 0.f}, (f32x4){0.f, 0.f, 0.f, 0.f}};
        sk_accum(a, A, K, Bt + (size_t)col0 * K, K, X.wid, X.lane);
        __syncthreads();
        const f32x4 v = sk_reduce(X.lds, 0, a, X.wid, X.lane);
        if (X.wid < 2) {
            const int t = 16 * X.wid + (X.lane & 15), c = col0 + 4 * (X.lane >> 4), mb = NBP + t;
            const f32x4 xr = *(const f32x4*)(xres + (size_t)t * D + c), g = *(const f32x4*)(gate + (size_t)mb * 6144 + c);
            const f32x4 o = xr + g * v;
            *(f32x4*)(XO + (size_t)t * D + c) = o;
            float ss = (o[0] * o[0] + o[1] * o[1]) + (o[2] * o[2] + o[3] * o[3]);
            ss += __shfl_xor(ss, 16); ss += __shfl_xor(ss, 32);
            if ((X.lane >> 4) == 0) SSS[t * 64 + it] = ss;
            if (XG) {
                const f32x4 n = *(const f32x4*)(normg + c), s1 = *(const f32x4*)(sc + (size_t)mb * 6144 + c);
                const f32x4 y = o * n * (s1 + 1.0f);
                u32x2 w; w.x = cvt_pk_bf16(y[0], y[1]); w.y = cvt_pk_bf16(y[2], y[3]);
                *(u32x2*)(XG + (size_t)t * D + c) = w;
            }
        }
        __syncthreads();
    }
}
__device__ __forceinline__ void samp_up(const Ctx& X, int layer) {
    unsigned char* ws = X.ws; unsigned char* wl = ws + WS_W + (size_t)layer * WL_SIZE;
    for (int it = X.bid; it < 256; it += X.G) {
        const int col0 = it * 16;
        f32x4 a[2] = {(f32x4){0.f, 0.f, 0.f, 0.f}, (f32x4){0.f, 0.f, 0.f, 0.f}};
        sk_accum(a, (const bf16_t*)(ws + WS_XG2) + (size_t)MP * D, D, (const bf16_t*)(wl + WL_UP) + (size_t)col0 * D, D, X.wid, X.lane);
        __syncthreads();
        const f32x4 v = sk_reduce(X.lds, 0, a, X.wid, X.lane);
        if (X.wid < 2) {
            const int t = 16 * X.wid + (X.lane & 15), c = col0 + 4 * (X.lane >> 4), mb = NBP + t;
            const float rstd = samp_rstd((const float*)(ws + WS_SSSB), t);
            const f32x4 b = *(const f32x4*)((const float*)(ws + WS_BIAS2) + ((size_t)layer * NMB + mb) * DFF + c);
            f32x4 o = v * rstd + b;
#pragma unroll
            for (int i = 0; i < 4; ++i) { const float q = fmaxf(o[i], 0.f); o[i] = q * q; }
            u32x2 w; w.x = cvt_pk_bf16(o[0], o[1]); w.y = cvt_pk_bf16(o[2], o[3]);
            *(u32x2*)((bf16_t*)(ws + WS_U) + ((size_t)MP + t) * DFF + c) = w;
        }
        __syncthreads();
    }
}

#define XB_TMO      128
#define XB_XCNT(j)  (256  + 64 * (j))
#define XB_XSUB(j)  (1280 + 64 * (j))
#define XB_XGEN(j)  (2304 + 64 * (j))
#define XB_TOP      3328
#define XB_TOPGEN   3392
#define XCD_BAR_WORDS 3456
#define XB_SPIN_CAP (1u << 18)
__device__ __forceinline__ unsigned xb_ld(unsigned* p)              { return __hip_atomic_load(p, __ATOMIC_RELAXED, __HIP_MEMORY_SCOPE_AGENT); }
__device__ __forceinline__ unsigned xb_add(unsigned* p, unsigned v) { return __hip_atomic_fetch_add(p, v, __ATOMIC_RELAXED, __HIP_MEMORY_SCOPE_AGENT); }
__device__ __forceinline__ unsigned xb_xcc_id() { return (unsigned)__builtin_amdgcn_s_getreg((3 << 11) | 20) & 0xFu; }
#define XB_SPIN(cond, bar) do { unsigned _sp = 0; while (cond) { __builtin_amdgcn_s_sleep(1); \
    if ((++_sp & 255u) == 0u) { if (xb_ld(&(bar)[XB_TMO])) break; if (_sp > XB_SPIN_CAP) { atomicAdd(&(bar)[XB_TMO], 1u); break; } } } } while (0)
struct XcdBarrier { unsigned* bar; unsigned x; volatile LAS unsigned* st; };
__device__ __forceinline__ XcdBarrier xcd_barrier_post(unsigned* bar, volatile LAS unsigned* st) {
    XcdBarrier b; b.bar = bar; b.x = xb_xcc_id(); b.st = st;
    if (threadIdx.x == 0) (void)xb_add(&bar[XB_XCNT(b.x)], 1u);
    return b;
}
__device__ __forceinline__ void xcd_barrier_complete(unsigned* bar, unsigned x, unsigned& nloc, unsigned& nx) {
    const unsigned G = gridDim.x * gridDim.y * gridDim.z;
    unsigned sum, cnt, mine, sp = 0u;
    for (;;) {
        sum = 0u; cnt = 0u; mine = 0u;
#pragma unroll
        for (unsigned j = 0; j < 16; ++j) { const unsigned c = xb_ld(&bar[XB_XCNT(j)]); sum += c; cnt += (c > 0u) ? 1u : 0u; mine = (j == x) ? c : mine; }
        if (sum == G) break;
        __builtin_amdgcn_s_sleep(1);
        if ((++sp & 255u) == 0u) { if (xb_ld(&bar[XB_TMO])) break; if (sp > XB_SPIN_CAP) { atomicAdd(&bar[XB_TMO], 1u); break; } }
    }
    nloc = mine > 0u ? mine : 1u; nx = cnt > 0u ? cnt : 1u;
}
__device__ __forceinline__ void xcd_barrier(const XcdBarrier& b) {
    asm volatile("s_waitcnt vmcnt(0)" ::: "memory");
    __syncthreads();
    if (threadIdx.x == 0) {
        unsigned* bar = b.bar;
        __builtin_amdgcn_s_waitcnt(0);
        unsigned nloc = b.st[0], nx = b.st[1];
        if (nloc == 0u) { xcd_barrier_complete(bar, b.x, nloc, nx); b.st[0] = nloc; b.st[1] = nx; }
        const unsigned old = xb_add(&bar[XB_XSUB(b.x)], 1u);
        const unsigned gen = old / nloc;
        if (old + 1u == (gen + 1u) * nloc) {
            __builtin_amdgcn_fence(__ATOMIC_RELEASE, "agent");
            asm volatile("s_waitcnt vmcnt(0)" ::: "memory");
            const unsigned og = xb_add(&bar[XB_TOP], 1u);
            const unsigned tg = og / nx;
            if (og + 1u == (tg + 1u) * nx) xb_add(&bar[XB_TOPGEN], 1u);
            else XB_SPIN(xb_ld(&bar[XB_TOPGEN]) == tg, bar);
            __builtin_amdgcn_fence(__ATOMIC_ACQUIRE, "agent");
            xb_add(&bar[XB_XGEN(b.x)], 1u);
            asm volatile("s_waitcnt vmcnt(0)" ::: "memory");
        } else {
            XB_SPIN(xb_ld(&bar[XB_XGEN(b.x)]) == gen, bar);
            __builtin_amdgcn_fence(__ATOMIC_ACQUIRE, "agent");
            asm volatile("s_waitcnt vmcnt(0)" ::: "memory");
        }
    }
    __syncthreads();
}
constexpr int LDS_BAR_OFF = 139264;

constexpr int N_PHASES = 2 + 8 * NLAYER + 1;

__global__ void __launch_bounds__(NTHREADS, 2) fwd_megakernel(Args args) {
    extern __shared__ __attribute__((aligned(16))) unsigned char lds_raw[];
    const int wid_ = __builtin_amdgcn_readfirstlane((int)threadIdx.x >> 6);
    const Ctx X{args, (LAS unsigned char*)lds_raw, 0, 0, wid_, (int)gridDim.x, (int)blockIdx.x, args.out, args.ws};
    const int lo = args.ph_lo, hi = args.ph_hi;
#if MK_ONE_LAUNCH
    cg::grid_group grid = cg::this_grid();
    if (threadIdx.x < 2) ((volatile LAS unsigned*)(X.lds + LDS_BAR_OFF))[threadIdx.x] = 0u;
    __syncthreads();
    const XcdBarrier xbar = xcd_barrier_post((unsigned*)(args.ws + WS_CTL), (volatile LAS unsigned*)(X.lds + LDS_BAR_OFF));
#define SEAM() xcd_barrier(xbar)
#else
#define SEAM() do {} while (0)
#endif
#ifndef PHMASK
#define PHMASK 0xFFFFFFFFu
#endif
#define PHON(j) ((PHMASK >> (j)) & 1u)
#ifndef REPMASK
#define REPMASK 0u
#endif
#define NREP(j) (1 + ((REPMASK >> (j)) & 1u))
#define IN(k) (lo <= (k) && (k) < hi)
#define SEAM_AFTER(k) do { if (IN(k) && IN((k) + 1)) SEAM(); } while (0)
    if (PHON(0) && IN(0)) { for (int rep = 0; rep < NREP(0); ++rep) { if (rep) SEAM(); phase_p0a(X); } }
#if MK_ONE_LAUNCH
    if (IN(0) && IN(1)) grid.sync();
#endif
    if (PHON(1) && IN(1)) { for (int rep = 0; rep < NREP(1); ++rep) { if (rep) SEAM(); phase_p0b(X); } } SEAM_AFTER(1);
    for (int l = 0; l < NLAYER; ++l) {
        const int pb = 2 + 8 * l;
        if (PHON(2) && IN(pb + 0)) for (int rep = 0; rep < (int)NREP(2); ++rep) { if (rep) SEAM();
            const Ctx Y = relaunder(X); unsigned char* ws = Y.ws; unsigned char* wl = ws + WS_W + (size_t)l * WL_SIZE; const float* MOD = (const float*)(ws + WS_MOD); (void)MOD;
            pg8::Gemm g{(const bf16_t*)(ws + WS_XG1), (const bf16_t*)(wl + WL_IN), M, NINP, D}; SchedG1 S; S.init(Y.G, Y.bid);
            EpiIn E{(bf16_t*)(ws + WS_ACT), (float*)(ws + WS_DT), (bf16_t*)(ws + WS_VT), (const float*)(ws + WS_SSA), (const float*)(ws + WS_SSSA), (const float*)(ws + WS_BIAS1) + (size_t)l * NMB * NINP, args.in[IN_DTB] + l * NH};
            pg8::gemm_phase<EpiIn, SchedG1, true, true>(Y.lds, g, S, E, Y.wid);
        }
        SEAM_AFTER(pb + 0);
        if (PHON(3) && IN(pb + 1)) phase_p2a(X, l);
        SEAM_AFTER(pb + 1);
        if (PHON(3) && IN(pb + 7)) phase_p2b(X, l);
        if (IN(pb + 7) && IN(pb + 2)) SEAM();
        if (PHON(4) && IN(pb + 2)) { for (int rep = 0; rep < NREP(4); ++rep) { if (rep) SEAM(); phase_p3(X, l); } }
        SEAM_AFTER(pb + 2);
        if (PHON(5) && IN(pb + 3)) for (int rep = 0; rep < (int)NREP(5); ++rep) { if (rep) SEAM();
            const Ctx Y = relaunder(X); unsigned char* ws = Y.ws; unsigned char* wl = ws + WS_W + (size_t)l * WL_SIZE; const float* MOD = (const float*)(ws + WS_MOD); (void)MOD; (void)wl;
#ifndef G4MASK
#define G4MASK 3
#endif
            samp_g4(Y, l);
            if (G4MASK & 1) { pg8::Gemm g{(const bf16_t*)(ws + WS_ATTN), (const bf16_t*)(wl + WL_OA), MP, D, 256}; pg8::StaticOrder S; S.init(MP, D, Y.G, Y.bid);
              EpiT1 E{(const bf16_t*)(ws + WS_ACT), (float*)(ws + WS_T1)};
              pg8::gemm_phase<EpiT1, pg8::StaticOrder, true, true>(Y.lds, g, S, E, Y.wid); }
            if (G4MASK & 2) { pg8::Gemm g{(const bf16_t*)(ws + WS_SSDN), (const bf16_t*)(wl + WL_OS), MP, D, DIN}; pg8::StaticOrder S; S.init(MP, D, Y.G, Y.bid);
              EpiMerge E{(const bf16_t*)(ws + WS_ACT), (const float*)(ws + WS_T1), (bf16_t*)(ws + WS_MERGED)};
              pg8::gemm_phase<EpiMerge, pg8::StaticOrder, true, true>(Y.lds, g, S, E, Y.wid); }
        }
        SEAM_AFTER(pb + 3);
        if (PHON(6) && IN(pb + 4)) for (int rep = 0; rep < (int)NREP(6); ++rep) { if (rep) SEAM();
            const Ctx Y = relaunder(X); unsigned char* ws = Y.ws; unsigned char* wl = ws + WS_W + (size_t)l * WL_SIZE; const float* MOD = (const float*)(ws + WS_MOD); (void)MOD; (void)wl;
            const float* xp = l == 0 ? args.in[IN_X_P] : (const float*)(ws + WS_XA); const float* xs = l == 0 ? args.in[IN_X_S] : (const float*)(ws + WS_XA) + (size_t)MP * D;
            samp_res(Y, (const bf16_t*)(ws + WS_MERGED) + (size_t)MP * D, D, (const bf16_t*)(wl + WL_OUT), xs, MOD + (size_t)l * NMB * 6144 + 2048, (float*)(ws + WS_X1) + (size_t)MP * D, (float*)(ws + WS_SSSB),
                     (bf16_t*)(ws + WS_XG2) + (size_t)MP * D, args.in[IN_N2G] + (size_t)l * D, MOD + (size_t)l * NMB * 6144 + 4096);
            pg8::Gemm g{(const bf16_t*)(ws + WS_MERGED), (const bf16_t*)(wl + WL_OUT), MP, D, D}; pg8::StaticOrder S; S.init(MP, D, Y.G, Y.bid);
            EpiRes<true> E{xp, MOD + (size_t)l * NMB * 6144 + 2048, (float*)(ws + WS_X1), (float*)(ws + WS_SSB), (bf16_t*)(ws + WS_XG2), args.in[IN_N2G] + (size_t)l * D, MOD + (size_t)l * NMB * 6144 + 4096, Y.lds};
            pg8::gemm_phase<EpiRes<true>, pg8::StaticOrder, true, true>(Y.lds, g, S, E, Y.wid);
        }
        SEAM_AFTER(pb + 4);
        if (PHON(7) && IN(pb + 5)) for (int rep = 0; rep < (int)NREP(7); ++rep) { if (rep) SEAM();
            const Ctx Y = relaunder(X); unsigned char* ws = Y.ws; unsigned char* wl = ws + WS_W + (size_t)l * WL_SIZE; const float* MOD = (const float*)(ws + WS_MOD); (void)MOD; (void)wl;
            samp_up(Y, l);
            pg8::Gemm g{(const bf16_t*)(ws + WS_XG2), (const bf16_t*)(wl + WL_UP), MP, DFF, D}; pg8::StaticOrder S; S.init(MP, DFF, Y.G, Y.bid);
            EpiUp E{(bf16_t*)(ws + WS_U), (const float*)(ws + WS_SSB), (const float*)(ws + WS_BIAS2) + (size_t)l * NMB * DFF};
            pg8::gemm_phase<EpiUp, pg8::StaticOrder, true, true>(Y.lds, g, S, E, Y.wid);
        }
        SEAM_AFTER(pb + 5);
        if (PHON(8) && IN(pb + 6)) for (int rep = 0; rep < (int)NREP(8); ++rep) { if (rep) SEAM();
            const Ctx Y = relaunder(X); unsigned char* ws = Y.ws; unsigned char* wl = ws + WS_W + (size_t)l * WL_SIZE; const float* MOD = (const float*)(ws + WS_MOD); (void)MOD; (void)wl;
            const float* x1 = (const float*)(ws + WS_X1);
            samp_res(Y, (const bf16_t*)(ws + WS_U) + (size_t)MP * DFF, DFF, (const bf16_t*)(wl + WL_DN), x1 + (size_t)MP * D, MOD + (size_t)l * NMB * 6144 + 5120, (float*)(ws + WS_XA) + (size_t)MP * D, (float*)(ws + WS_SSSA),
                     l + 1 < NLAYER ? (bf16_t*)(ws + WS_XG1) + (size_t)MP * D : nullptr, args.in[IN_N1G] + (size_t)(l + 1 < NLAYER ? l + 1 : l) * D, MOD + (size_t)(l + 1 < NLAYER ? l + 1 : l) * NMB * 6144 + 1024);
            pg8::Gemm g{(const bf16_t*)(ws + WS_U), (const bf16_t*)(wl + WL_DN), MP, D, DFF}; pg8::StaticOrder S; S.init(MP, D, Y.G, Y.bid);
            if (l + 1 < NLAYER) {
                EpiRes<true> E{x1, MOD + (size_t)l * NMB * 6144 + 5120, (float*)(ws + WS_XA), (float*)(ws + WS_SSA), (bf16_t*)(ws + WS_XG1), args.in[IN_N1G] + (size_t)(l + 1) * D, MOD + (size_t)(l + 1) * NMB * 6144 + 1024, Y.lds};
                pg8::gemm_phase<EpiRes<true>, pg8::StaticOrder, true, true>(Y.lds, g, S, E, Y.wid);
            } else {
                EpiRes<false> E{x1, MOD + (size_t)l * NMB * 6144 + 5120, (float*)(ws + WS_XA), (float*)(ws + WS_SSA), nullptr, nullptr, nullptr, Y.lds};
                pg8::gemm_phase<EpiRes<false>, pg8::StaticOrder, true, true>(Y.lds, g, S, E, Y.wid);
            }
        }
        SEAM_AFTER(pb + 6);
    }
    if (PHON(9) && IN(N_PHASES - 1)) phase_final(X);
#undef IN
#undef SEAM_AFTER
#undef SEAM
}

extern "C" void kernel_launch(void* const* d_in, const int* in_sizes, int n_in, void* d_out, int out_size, void* d_ws, size_t ws_size, hipStream_t stream) {
    static int grid = 0;
    if (grid == 0) {
        if (n_in != 27 || (size_t)out_size != O_END || ws_size < WS_END) { fprintf(stderr, "kernel_launch: unexpected shapes: n_in %d out %d (want %zu) ws %zu (want %zu)\n", n_in, out_size, (size_t)O_END, ws_size, (size_t)WS_END); grid = -1; return; }
        int dev = 0, cus = 0, per_cu = 0;
        hipGetDevice(&dev); hipDeviceGetAttribute(&cus, hipDeviceAttributeMultiprocessorCount, dev);
        if (hipFuncSetAttribute((const void*)fwd_megakernel, hipFuncAttributeMaxDynamicSharedMemorySize, LDS_BYTES) != hipSuccess) { fprintf(stderr, "kernel_launch: hipFuncSetAttribute failed\n"); grid = -1; return; }
        if (hipOccupancyMaxActiveBlocksPerMultiprocessor(&per_cu, (const void*)fwd_megakernel, NTHREADS, LDS_BYTES) != hipSuccess || per_cu < 1) { fprintf(stderr, "kernel_launch: occupancy query says %d\n", per_cu); per_cu = 1; }
        (void)hipGetLastError();
        grid = cus;
    }
    if (grid < 0) return;
    if (hipMemsetAsync((char*)d_ws + WS_CTL, 0, 16384, stream) != hipSuccess) { fprintf(stderr, "kernel_launch: memset failed\n"); return; }
    Args a{};
    for (int i = 0; i < 27; ++i) a.in[i] = (const float*)d_in[i];
    a.out = (float*)d_out; a.ws = (unsigned char*)d_ws;
#if MK_ONE_LAUNCH
    a.ph_lo = 0; a.ph_hi = N_PHASES;
    void* kargs[] = {&a};
    hipError_t e = hipLaunchCooperativeKernel((const void*)fwd_megakernel, dim3(grid), dim3(NTHREADS), kargs, LDS_BYTES, stream);
    if (e != hipSuccess) fprintf(stderr, "cooperative launch failed: %s (grid %d)\n", hipGetErrorString(e), grid);
#else
    for (int p = 0; p < N_PHASES; ++p) { a.ph_lo = p; a.ph_hi = p + 1; hipLaunchKernelGGL(fwd_megakernel, dim3(grid), dim3(NTHREADS), LDS_BYTES, stream, a); }
#endif
}
```
